# Optimizing an MI355X kernel written in HIP

```python
import math
import jax, jax.numpy as jnp
from jax import lax
import numpy as np

D_MODEL = 2048
BATCH = 4
SEQ = 4096
DEPTH = 2

MEM_LEN = 256
CHUNK = 128
WINDOW = 128
G_GROUPS = 4
G_WIDTH = 1024
G_GROUP_DIM = G_WIDTH // G_GROUPS
SWA_HEADS = 16
SWA_KV_HEADS = 4
SWA_HEAD_DIM = 64
SWA_REP = SWA_HEADS // SWA_KV_HEADS
SWA_WIDTH = SWA_HEADS * SWA_HEAD_DIM
SWA_KV_WIDTH = SWA_KV_HEADS * SWA_HEAD_DIM
MEM_HEADS = 4
MEM_HEAD_DIM = 256
MEM_WIDTH = MEM_HEADS * MEM_HEAD_DIM
N_BRANCH = 3
BRANCH_WIDTH = 1024
D_FF = 5504
EPS = 1e-6
NEG = -1e30
IN_WIDTH = 2 * G_WIDTH + SWA_WIDTH + 2 * SWA_KV_WIDTH + MEM_WIDTH + N_BRANCH * D_MODEL

kernel_name = "hybrid_gated_gmlp_swa_memattn_macaron"


def rmsnorm(x, g):
    xf = x.astype(jnp.float32)
    y = xf * lax.rsqrt(jnp.mean(xf * xf, axis=-1, keepdims=True) + EPS)
    return (y * g.astype(jnp.float32)).astype(x.dtype)


def layernorm(x, g, b):
    xf = x.astype(jnp.float32)
    mu = jnp.mean(xf, axis=-1, keepdims=True)
    xc = xf - mu
    var = jnp.mean(xc * xc, axis=-1, keepdims=True)
    y = xc * lax.rsqrt(var + EPS) * g.astype(jnp.float32) + b.astype(jnp.float32)
    return y.astype(x.dtype)


def swiglu(x, w_in, w_out):
    a, b = jnp.split(x @ w_in, 2, axis=-1)
    return (jax.nn.silu(a) * b) @ w_out


def gmlp_branch(u, v, w_s, b_s, ln_g, ln_b):
    B, S, _ = u.shape
    n_chunks = S // CHUNK
    vn = layernorm(v, ln_g, ln_b).reshape(B, n_chunks, CHUNK, G_GROUPS, G_GROUP_DIM)
    causal = jnp.tril(jnp.ones((CHUNK, CHUNK), dtype=bool))
    ws = jnp.where(causal[None], w_s, jnp.zeros((), w_s.dtype))
    mixed = jnp.einsum('gts,bcsgd->bctgd', ws, vn) + jnp.transpose(b_s)[None, None, :, :, None]
    return u * mixed.reshape(B, S, G_WIDTH)


def swa_branch(q, k, v, sinks):
    B, S = q.shape[0], q.shape[1]
    nb = S // WINDOW
    qb = q.reshape(B, nb, WINDOW, SWA_KV_HEADS, SWA_REP, SWA_HEAD_DIM)

    def band(t):
        prev = jnp.pad(t, ((0, 0), (WINDOW, 0), (0, 0), (0, 0)))[:, :S]
        prev = prev.reshape(B, nb, WINDOW, SWA_KV_HEADS, SWA_HEAD_DIM)
        cur = t.reshape(B, nb, WINDOW, SWA_KV_HEADS, SWA_HEAD_DIM)
        return jnp.concatenate([prev, cur], axis=2)

    kb, vb = band(k), band(v)
    scale = 1.0 / math.sqrt(SWA_HEAD_DIM)
    scores = jnp.einsum('bcihrd,bcjhd->bchrij', qb, kb).astype(jnp.float32) * scale
    i = jnp.arange(WINDOW)[:, None]
    j = jnp.arange(2 * WINDOW)[None, :]
    dist = i + WINDOW - j
    key_pos = jnp.arange(nb)[:, None, None] * WINDOW - WINDOW + j[None]
    valid = (dist >= 0)[None] & (dist < WINDOW)[None] & (key_pos >= 0)
    slopes = jnp.exp2(-8.0 * jnp.arange(1, SWA_HEADS + 1, dtype=jnp.float32) / SWA_HEADS)
    slopes = slopes.reshape(SWA_KV_HEADS, SWA_REP)
    alibi = -slopes[:, :, None, None] * dist.astype(jnp.float32)[None, None]
    scores = jnp.where(valid[None, :, None, None], scores + alibi[None, None], NEG)
    sink = sinks.astype(jnp.float32).reshape(SWA_KV_HEADS, SWA_REP)[None, None, :, :, None, None]
    m = jnp.maximum(jnp.max(scores, axis=-1, keepdims=True), sink)
    p = jnp.exp(scores - m)
    denom = jnp.sum(p, axis=-1, keepdims=True) + jnp.exp(sink - m)
    probs = (p / denom).astype(vb.dtype)
    out = jnp.einsum('bchrij,bcjhd->bcihrd', probs, vb)
    return out.reshape(B, S, SWA_WIDTH)


def mem_branch(q, mk, mv):
    B, S = q.shape[0], q.shape[1]
    scale = 1.0 / math.sqrt(MEM_HEAD_DIM)
    scores = jnp.einsum('bshd,bmhd->bhsm', q, mk).astype(jnp.float32) * scale
    probs = jax.nn.softmax(scores, axis=-1).astype(mv.dtype)
    return jnp.einsum('bhsm,bmhd->bshd', probs, mv).reshape(B, S, MEM_WIDTH)


def setup_inputs(seed: int = 0) -> dict:
    key = jax.random.key(seed)
    ks = jax.random.split(key, 24)
    f32 = jnp.float32
    nrm = lambda k, shape, s: jax.random.normal(k, shape, f32) * s
    gain = lambda k, shape: 1.0 + 0.02 * jax.random.normal(k, shape, f32)
    return {
        "x": nrm(ks[0], (BATCH, SEQ, D_MODEL), 1.0),
        "mem": nrm(ks[1], (BATCH, MEM_LEN, D_MODEL), 1.0),
        "g_ffn1": gain(ks[2], (DEPTH, D_MODEL)),
        "w_ffn1_in": nrm(ks[3], (DEPTH, D_MODEL, 2 * D_FF), D_MODEL ** -0.5),
        "w_ffn1_out": nrm(ks[4], (DEPTH, D_FF, D_MODEL), D_FF ** -0.5),
        "g_mix": gain(ks[5], (DEPTH, D_MODEL)),
        "w_in": nrm(ks[6], (DEPTH, D_MODEL, IN_WIDTH), D_MODEL ** -0.5),
        "gmlp_ln_g": gain(ks[7], (DEPTH, G_WIDTH)),
        "gmlp_ln_b": nrm(ks[8], (DEPTH, G_WIDTH), 0.02),
        "w_s": nrm(ks[9], (DEPTH, G_GROUPS, CHUNK, CHUNK), CHUNK ** -0.5),
        "b_s": gain(ks[10], (DEPTH, G_GROUPS, CHUNK)),
        "swa_sinks": nrm(ks[11], (DEPTH, SWA_HEADS), 0.5),
        "g_mem": gain(ks[12], (DEPTH, D_MODEL)),
        "w_mem_kv": nrm(ks[13], (DEPTH, D_MODEL, 2 * MEM_WIDTH), D_MODEL ** -0.5),
        "w_branch": nrm(ks[14], (DEPTH, N_BRANCH, BRANCH_WIDTH, D_MODEL), BRANCH_WIDTH ** -0.5),
        "w_out": nrm(ks[15], (DEPTH, D_MODEL, D_MODEL), D_MODEL ** -0.5),
        "g_ffn2": gain(ks[16], (DEPTH, D_MODEL)),
        "w_ffn2_in": nrm(ks[17], (DEPTH, D_MODEL, 2 * D_FF), D_MODEL ** -0.5),
        "w_ffn2_out": nrm(ks[18], (DEPTH, D_FF, D_MODEL), D_FF ** -0.5),
        "g_final": gain(ks[19], (D_MODEL,)),
    }


def reference(x, mem, g_ffn1, w_ffn1_in, w_ffn1_out, g_mix, w_in, gmlp_ln_g, gmlp_ln_b,
              w_s, b_s, swa_sinks, g_mem, w_mem_kv, w_branch, w_out, g_ffn2, w_ffn2_in,
              w_ffn2_out, g_final):
    B, S, _ = x.shape
    split_at = list(np.cumsum([G_WIDTH, G_WIDTH, SWA_WIDTH, SWA_KV_WIDTH, SWA_KV_WIDTH, MEM_WIDTH]))
    for l in range(DEPTH):
        h = x + 0.5 * swiglu(rmsnorm(x, g_ffn1[l]), w_ffn1_in[l], w_ffn1_out[l])
        n = rmsnorm(h, g_mix[l])
        z = n @ w_in[l]
        z_u, z_v, z_q, z_k, z_vv, z_mq, z_gate = jnp.split(z, split_at, axis=-1)
        o_a = gmlp_branch(jax.nn.gelu(z_u, approximate=False), jax.nn.gelu(z_v, approximate=False),
                          w_s[l], b_s[l], gmlp_ln_g[l], gmlp_ln_b[l])
        o_b = swa_branch(z_q.reshape(B, S, SWA_HEADS, SWA_HEAD_DIM),
                         z_k.reshape(B, S, SWA_KV_HEADS, SWA_HEAD_DIM),
                         z_vv.reshape(B, S, SWA_KV_HEADS, SWA_HEAD_DIM),
                         swa_sinks[l])
        mkv = rmsnorm(mem, g_mem[l]) @ w_mem_kv[l]
        mk, mv = jnp.split(mkv, 2, axis=-1)
        o_c = mem_branch(z_mq.reshape(B, S, MEM_HEADS, MEM_HEAD_DIM),
                         mk.reshape(B, MEM_LEN, MEM_HEADS, MEM_HEAD_DIM),
                         mv.reshape(B, MEM_LEN, MEM_HEADS, MEM_HEAD_DIM))
        gates = jax.nn.sigmoid(z_gate.reshape(B, S, N_BRANCH, D_MODEL))
        y = (gates[:, :, 0] * (o_a @ w_branch[l, 0])
             + gates[:, :, 1] * (o_b @ w_branch[l, 1])
             + gates[:, :, 2] * (o_c @ w_branch[l, 2]))
        h = h + y @ w_out[l]
        x = h + 0.5 * swiglu(rmsnorm(h, g_ffn2[l]), w_ffn2_in[l], w_ffn2_out[l])
    return rmsnorm(x, g_final)
```

```cpp
#include <hip/hip_runtime.h>
#include <hip/hip_cooperative_groups.h>
#include <cstdio>
namespace cg = cooperative_groups;

#ifndef MK_COOP
#define MK_COOP 1
#endif
#ifndef DUP_MASK
#define DUP_MASK 0
#endif
#ifndef GEMM_REP
#define GEMM_REP 1
#endif
#ifndef SYNC_REP
#define SYNC_REP 1
#endif
#ifndef WIN_REP
#define WIN_REP 1
#endif
#ifndef EPI_REP
#define EPI_REP 1
#endif
#ifndef FOUT_REP
#define FOUT_REP 1
#endif
#ifndef NORM_REP
#define NORM_REP 1
#endif
#ifndef CONV_REP
#define CONV_REP 1
#endif
#ifndef MIXA_REP
#define MIXA_REP 1
#endif
#ifndef MIXB_REP
#define MIXB_REP 1
#endif
#ifndef MIXC_REP
#define MIXC_REP 1
#endif
#ifndef NAIVE_A
#define NAIVE_A 0
#endif
#ifndef NAIVE_B
#define NAIVE_B 0
#endif
#ifndef NAIVE_C
#define NAIVE_C 0
#endif

constexpr int T_TOK = 16384, DM = 2048, DFF = 5504, SEQ = 4096, NB = 4, MEML = 256;
constexpr int INW = 10752, ZAW = 4608, ZGW = 6144;
constexpr int ZU = 0, ZV = 1024, ZQ = 2048, ZK = 3072, ZVV = 3328, ZMQ = 3584;
constexpr int PH_PER_LAYER = 11, N_PHASES = 2 * PH_PER_LAYER + 1;

namespace pg8 {
#define PG8_LAS __attribute__((address_space(3)))
typedef unsigned short bf16_t;
typedef short bf16x8 __attribute__((ext_vector_type(8)));
typedef float f32x4 __attribute__((ext_vector_type(4)));
typedef unsigned u32x4 __attribute__((ext_vector_type(4)));
constexpr int BM = 256, BK = 64, HALF = 128, HTB = HALF * BK * 2  , STAGE_BYTES = 8 * HTB, NXCD = 8, WGM = 8;

__host__ __device__ __forceinline__ int lds_byte(int r, int c) { const int st = (r >> 4) * 2 + (c >> 5), rr = r & 15, cc = c & 31, ob = rr * 64 + cc * 2; return st * 1024 + (ob ^ (((ob >> 9) & 1) << 5)); }
__host__ __device__ __forceinline__ void stage_rc(int b, int& R, int& C) { const int st = b / 1024, sb = b % 1024, swz = sb ^ (((sb >> 9) & 1) << 5); R = (st >> 1) * 16 + swz / 64; C = (st & 1) * 32 + (swz % 64) / 2; }
__host__ __device__ __forceinline__ int perm32(int rho) { const int n = rho >> 4, i = rho & 15; return 8 * (i >> 2) + 4 * n + (i & 3); }

struct Unit { int pm, pn, br; };
struct Gemm { const bf16_t* A; const bf16_t* Bt; int M, N, K; size_t strideA = 0, strideB = 0; };

struct StaticOrder {
    int nM, nN, nwg, G, c; int rep = 1; int wgm = WGM;
    __host__ __device__ void init(int M, int N, int G_, int c_) { nM = M / BM; nN = N / BM; nwg = nM * nN; G = G_; c = c_; }
    __host__ __device__ bool next(int i, Unit& u) const {
        const long L = (long)i * G + c; if (L >= (long)nwg * rep) return false;
        int wgid = (int)(L % nwg); { const int q = nwg / NXCD, r = nwg % NXCD, xcd = wgid % NXCD, off = wgid / NXCD; wgid = (xcd < r ? xcd * (q + 1) : r * (q + 1) + (xcd - r) * q) + off; }
        const int nig = wgm * nN, gid = wgid / nig, fm = gid * wgm, gsz = (nM - fm) < wgm ? (nM - fm) : wgm;
        u.pm = fm + ((wgid % nig) % gsz); u.pn = (wgid % nig) / gsz; u.br = 0; return true;
    }
    __device__ __forceinline__ void a_ready(const Unit&) const {}
    __device__ __forceinline__ void done(const Unit&) const {}
};
struct ChainOrder : StaticOrder {
    __host__ __device__ bool next(int i, Unit& u) const { const int j = i / 3; if (!StaticOrder::next(j, u)) return false; u.br = i - 3 * j; return true; }
};

__device__ __forceinline__ unsigned cvt_pk_bf16(float lo, float hi) { unsigned r; asm volatile("v_cvt_pk_bf16_f32 %0, %1, %2" : "=v"(r) : "v"(lo), "v"(hi)); return r; }
typedef float f32x2 __attribute__((ext_vector_type(2)));
__device__ __forceinline__ f32x2 gelu_pk(f32x2 v) {
    const f32x2 av = __builtin_elementwise_abs(v), d = av * 0.2316418882f + 1.0f;
    f32x2 t; t.x = __builtin_amdgcn_rcpf(d.x); t.y = __builtin_amdgcn_rcpf(d.y);
    f32x2 q = t * 0.5307027145f + (-0.7265760135f); q = q * t + 0.7107068705f; q = q * t + (-0.142248368f); q = q * t + 0.127414796f; q = q * t;
    const f32x2 s = (v * v) * (-0.72134752044f);
    f32x2 e; e.x = __builtin_amdgcn_exp2f(s.x); e.y = __builtin_amdgcn_exp2f(s.y);
    const f32x2 m = v * (q * e), r = v - m;
    f32x2 o; o.x = v.x < 0.f ? m.x : r.x; o.y = v.y < 0.f ? m.y : r.y; return o;
}
__device__ __forceinline__ float bf2f(bf16_t v) { return __uint_as_float(((unsigned)v) << 16); }
__device__ __forceinline__ float bflo(unsigned w) { return __uint_as_float(w << 16); }
__device__ __forceinline__ float bfhi(unsigned w) { return __uint_as_float(w & 0xffff0000u); }
__device__ __forceinline__ float fast_sigmoid(float x) { return __builtin_amdgcn_rcpf(1.0f + __expf(-x)); }

struct EpiSwiGLU {
    static constexpr bool PERM = true, AFTER_DRAIN = false, IDEMP = true, CHAIN = false;
    bf16_t* O; int ldc;
    __device__ __forceinline__ void operator()(const f32x4 (&acc)[2][2][4][2], const Unit& u, int wr, int wc, int fr, int fq) const {
        const int row0 = u.pm * BM + wr * 64 + fr; const int col0 = u.pn * HALF + wc * 32 + 8 * fq;
#pragma unroll
        for (int ai = 0; ai < 2; ++ai)
#pragma unroll
            for (int m = 0; m < 4; ++m) { bf16_t* rowp = O + (size_t)(row0 + ai * HALF + m * 16) * ldc + col0;
                f32x4 a0 = acc[ai][0][m][0], a1 = acc[ai][0][m][1], b0 = acc[ai][1][m][0], b1 = acc[ai][1][m][1]; f32x4 v0, v1;
#pragma unroll
                for (int j = 0; j < 4; ++j) { v0[j] = a0[j] * fast_sigmoid(a0[j]) * b0[j]; v1[j] = a1[j] * fast_sigmoid(a1[j]) * b1[j]; }
                u32x4 w; w.x = cvt_pk_bf16(v0[0], v0[1]); w.y = cvt_pk_bf16(v0[2], v0[3]); w.z = cvt_pk_bf16(v1[0], v1[1]); w.w = cvt_pk_bf16(v1[2], v1[3]);
                __builtin_nontemporal_store(w, (u32x4*)rowp); }
    }
};
template <bool FIRST> struct EpiResid16 {
    static constexpr bool PERM = true, AFTER_DRAIN = false, IDEMP = false, CHAIN = false;
    const float* X; bf16_t* H; float scale;
    __device__ __forceinline__ void operator()(const f32x4 (&acc)[2][2][4][2], const Unit& u, int wr, int wc, int fr, int fq) const {
        const int row0 = u.pm * BM + wr * 64 + fr, col0 = u.pn * BM + wc * 32 + 8 * fq;
        if (FIRST) {
#pragma unroll
            for (int ai = 0; ai < 2; ++ai)
#pragma unroll
                for (int m = 0; m < 4; ++m) { const size_t off = (size_t)(row0 + ai * HALF + m * 16) * 2048 + col0;
#pragma unroll
                    for (int bj = 0; bj < 2; ++bj) { const size_t o = off + bj * HALF; const f32x4 r0 = *(const f32x4*)(X + o), r1 = *(const f32x4*)(X + o + 4);
                        const f32x4 v0 = r0 + acc[ai][bj][m][0] * scale, v1 = r1 + acc[ai][bj][m][1] * scale;
                        u32x4 w; w.x = cvt_pk_bf16(v0[0], v0[1]); w.y = cvt_pk_bf16(v0[2], v0[3]); w.z = cvt_pk_bf16(v1[0], v1[1]); w.w = cvt_pk_bf16(v1[2], v1[3]);
                        *(u32x4*)(H + o) = w; } }
        } else {
            u32x4 hv[2][4][2];
#pragma unroll
            for (int ai = 0; ai < 2; ++ai)
#pragma unroll
                for (int m = 0; m < 4; ++m)
#pragma unroll
                    for (int bj = 0; bj < 2; ++bj) hv[ai][m][bj] = *(const u32x4*)(H + (size_t)(row0 + ai * HALF + m * 16) * 2048 + col0 + bj * HALF);
#pragma unroll
            for (int ai = 0; ai < 2; ++ai)
#pragma unroll
                for (int m = 0; m < 4; ++m)
#pragma unroll
                    for (int bj = 0; bj < 2; ++bj) { const size_t o = (size_t)(row0 + ai * HALF + m * 16) * 2048 + col0 + bj * HALF; const u32x4 h4 = hv[ai][m][bj];
                        const f32x4 r0 = (f32x4){bflo(h4.x), bfhi(h4.x), bflo(h4.y), bfhi(h4.y)}, r1 = (f32x4){bflo(h4.z), bfhi(h4.z), bflo(h4.w), bfhi(h4.w)};
                        const f32x4 v0 = r0 + acc[ai][bj][m][0] * scale, v1 = r1 + acc[ai][bj][m][1] * scale;
                        u32x4 w; w.x = cvt_pk_bf16(v0[0], v0[1]); w.y = cvt_pk_bf16(v0[2], v0[3]); w.z = cvt_pk_bf16(v1[0], v1[1]); w.w = cvt_pk_bf16(v1[2], v1[3]);
                        *(u32x4*)(H + o) = w; }
        }
    }
};
struct EpiPlainBf16 {
    static constexpr bool PERM = true, AFTER_DRAIN = false, IDEMP = false, CHAIN = false;
    bf16_t* O; int ldc;
    __device__ __forceinline__ void operator()(const f32x4 (&acc)[2][2][4][2], const Unit& u, int wr, int wc, int fr, int fq) const {
        const int row0 = u.pm * BM + wr * 64 + fr, col0 = u.pn * BM + wc * 32 + 8 * fq;
#pragma unroll
        for (int ai = 0; ai < 2; ++ai)
#pragma unroll
            for (int m = 0; m < 4; ++m) { bf16_t* rowp = O + (size_t)(row0 + ai * HALF + m * 16) * ldc + col0;
#pragma unroll
                for (int bj = 0; bj < 2; ++bj) { const f32x4 v0 = acc[ai][bj][m][0], v1 = acc[ai][bj][m][1];
                    u32x4 w; w.x = cvt_pk_bf16(v0[0], v0[1]); w.y = cvt_pk_bf16(v0[2], v0[3]); w.z = cvt_pk_bf16(v1[0], v1[1]); w.w = cvt_pk_bf16(v1[2], v1[3]);
                    *(u32x4*)(rowp + bj * HALF) = w; } }
    }
};
struct EpiWin {
    static constexpr bool PERM = true, AFTER_DRAIN = false, IDEMP = true, CHAIN = false;
    bf16_t* ZA; bf16_t* ZG;
    __device__ __forceinline__ void operator()(const f32x4 (&acc)[2][2][4][2], const Unit& u, int wr, int wc, int fr, int fq) const {
        const int row0 = u.pm * BM + wr * 64 + fr; const int pn = u.pn;
        const int mode = pn < 8 ? 1 : (pn < 18 ? 0 : 2);
        bf16_t* base = mode == 2 ? ZG : ZA; const int ldc = mode == 2 ? ZGW : ZAW; const int col0 = (mode == 2 ? (pn - 18) : pn) * BM + wc * 32 + 8 * fq;
#pragma unroll
        for (int ai = 0; ai < 2; ++ai)
#pragma unroll
            for (int m = 0; m < 4; ++m) { bf16_t* rowp = base + (size_t)(row0 + ai * HALF + m * 16) * ldc + col0;
#pragma unroll
                for (int bj = 0; bj < 2; ++bj) { f32x4 v0 = acc[ai][bj][m][0], v1 = acc[ai][bj][m][1];
                    if (mode == 1) { f32x2 a = gelu_pk((f32x2){v0[0], v0[1]}), b = gelu_pk((f32x2){v0[2], v0[3]}), c = gelu_pk((f32x2){v1[0], v1[1]}), d = gelu_pk((f32x2){v1[2], v1[3]});
                        v0 = (f32x4){a.x, a.y, b.x, b.y}; v1 = (f32x4){c.x, c.y, d.x, d.y}; }
                    else if (mode == 2) {
#pragma unroll
                        for (int j = 0; j < 4; ++j) { v0[j] = fast_sigmoid(v0[j]); v1[j] = fast_sigmoid(v1[j]); } }
                    u32x4 w; w.x = cvt_pk_bf16(v0[0], v0[1]); w.y = cvt_pk_bf16(v0[2], v0[3]); w.z = cvt_pk_bf16(v1[0], v1[1]); w.w = cvt_pk_bf16(v1[2], v1[3]);
                    __builtin_nontemporal_store(w, (u32x4*)(rowp + bj * HALF)); } }
    }
};
struct EpiMemKV {
    static constexpr bool PERM = true, AFTER_DRAIN = false, IDEMP = false, CHAIN = false;
    bf16_t* O; bf16_t* VT;
    __device__ __forceinline__ void operator()(const f32x4 (&acc)[2][2][4][2], const Unit& u, int wr, int wc, int fr, int fq) const {
        const int row0 = u.pm * BM + wr * 64 + fr, col0 = u.pn * BM + wc * 32 + 8 * fq;
#pragma unroll
        for (int ai = 0; ai < 2; ++ai)
#pragma unroll
            for (int m = 0; m < 4; ++m) { const int row = row0 + ai * HALF + m * 16;
#pragma unroll
                for (int bj = 0; bj < 2; ++bj) { const f32x4 v0 = acc[ai][bj][m][0], v1 = acc[ai][bj][m][1]; const int col = col0 + bj * HALF;
                    u32x4 w; w.x = cvt_pk_bf16(v0[0], v0[1]); w.y = cvt_pk_bf16(v0[2], v0[3]); w.z = cvt_pk_bf16(v1[0], v1[1]); w.w = cvt_pk_bf16(v1[2], v1[3]);
                    if (u.pn < 4) *(u32x4*)(O + (size_t)row * 2048 + col) = w;
                    else { const int cc = col - 1024, hh = cc >> 8, d = cc & 255, b = row >> 8, mm = row & 255; bf16_t* vt = VT + ((size_t)((b * 4 + hh) * 256 + d)) * 256 + mm;
                        vt[0] = (bf16_t)(w.x & 0xffffu); vt[256] = (bf16_t)(w.x >> 16); vt[512] = (bf16_t)(w.y & 0xffffu); vt[768] = (bf16_t)(w.y >> 16);
                        vt[1024] = (bf16_t)(w.z & 0xffffu); vt[1280] = (bf16_t)(w.z >> 16); vt[1536] = (bf16_t)(w.w & 0xffffu); vt[1792] = (bf16_t)(w.w >> 16); } } }
    }
};
struct EpiBranchChain {
    static constexpr bool PERM = true, AFTER_DRAIN = false, IDEMP = false, CHAIN = true;
    const bf16_t* G; bf16_t* YB;
    __device__ __forceinline__ void operator()(f32x4 (&acc)[2][2][4][2], const Unit& u, int wr, int wc, int fr, int fq) const {
        const int row0 = u.pm * BM + wr * 64 + fr, col0 = u.pn * BM + wc * 32 + 8 * fq; const int br = u.br;
#pragma unroll
        for (int ai = 0; ai < 2; ++ai) {
            u32x4 ga[4][2], gb[4][2];
#pragma unroll
            for (int m = 0; m < 4; ++m)
#pragma unroll
                for (int bj = 0; bj < 2; ++bj) { const bf16_t* gp = G + (size_t)(row0 + ai * HALF + m * 16) * ZGW + br * 2048 + col0 + bj * HALF;
                    ga[m][bj] = __builtin_nontemporal_load((const u32x4*)gp); if (br < 2) gb[m][bj] = __builtin_nontemporal_load((const u32x4*)(gp + 2048)); }
#pragma unroll
            for (int m = 0; m < 4; ++m) { const size_t row = (size_t)(row0 + ai * HALF + m * 16);
#pragma unroll
                for (int bj = 0; bj < 2; ++bj) { const int col = col0 + bj * HALF; const u32x4 a4 = ga[m][bj];
                    f32x4 g0 = (f32x4){bflo(a4.x), bfhi(a4.x), bflo(a4.y), bfhi(a4.y)}, g1 = (f32x4){bflo(a4.z), bfhi(a4.z), bflo(a4.w), bfhi(a4.w)};
                    if (br < 2) { const u32x4 b4 = gb[m][bj];
                        g0[0] *= __builtin_amdgcn_rcpf(bflo(b4.x)); g0[1] *= __builtin_amdgcn_rcpf(bfhi(b4.x)); g0[2] *= __builtin_amdgcn_rcpf(bflo(b4.y)); g0[3] *= __builtin_amdgcn_rcpf(bfhi(b4.y));
                        g1[0] *= __builtin_amdgcn_rcpf(bflo(b4.z)); g1[1] *= __builtin_amdgcn_rcpf(bfhi(b4.z)); g1[2] *= __builtin_amdgcn_rcpf(bflo(b4.w)); g1[3] *= __builtin_amdgcn_rcpf(bfhi(b4.w));
                        acc[ai][bj][m][0] *= g0; acc[ai][bj][m][1] *= g1; }
                    else { const f32x4 v0 = acc[ai][bj][m][0] * g0, v1 = acc[ai][bj][m][1] * g1;
                        u32x4 w; w.x = cvt_pk_bf16(v0[0], v0[1]); w.y = cvt_pk_bf16(v0[2], v0[3]); w.z = cvt_pk_bf16(v1[0], v1[1]); w.w = cvt_pk_bf16(v1[2], v1[3]);
                        *(u32x4*)(YB + row * 2048 + col) = w; } } }
        }
    }
};
template <int MODE> struct EpiBranch {
    static constexpr bool PERM = false, AFTER_DRAIN = false, IDEMP = false, CHAIN = false;
    const bf16_t* G; int gcol0; float* Y32; bf16_t* YB;
    __device__ __forceinline__ void operator()(const f32x4 (&acc)[2][2][4][2], const Unit& u, int wr, int wc, int fr, int fq) const {
        const int row0 = u.pm * BM + wr * 64 + fr, col0 = u.pn * BM + wc * 32 + 4 * fq;
#pragma unroll
        for (int ai = 0; ai < 2; ++ai)
#pragma unroll
            for (int m = 0; m < 4; ++m) { const size_t row = (size_t)(row0 + ai * HALF + m * 16);
#pragma unroll
                for (int bj = 0; bj < 2; ++bj)
#pragma unroll
                    for (int n = 0; n < 2; ++n) { const int col = col0 + bj * HALF + n * 16;
                        const uint2 gw = *(const uint2*)(G + row * ZGW + gcol0 + col);
                        f32x4 gv = (f32x4){bflo(gw.x), bfhi(gw.x), bflo(gw.y), bfhi(gw.y)};
                        f32x4 v = gv * acc[ai][bj][m][n];
                        if (MODE >= 1) v += *(const f32x4*)(Y32 + row * DM + col);
                        if (MODE <= 1) *(f32x4*)(Y32 + row * DM + col) = v;
                        else { uint2 w; w.x = cvt_pk_bf16(v[0], v[1]); w.y = cvt_pk_bf16(v[2], v[3]); *(uint2*)(YB + row * DM + col) = w; } } }
    }
};
template <class Epi, class Sched>
__device__ __forceinline__ void gemm_phase(PG8_LAS unsigned char* lds, const Gemm g, const Sched& S, const Epi& E) {
    int tix_ = threadIdx.x; asm volatile("" : "+v"(tix_));
    const int tid = tix_, wid = __builtin_amdgcn_readfirstlane(tid >> 6), lane = tid & 63, wr = wid >> 2, wc = wid & 3, fr = lane & 15, fq = lane >> 4;
    const int K = g.K, nt = K / BK;
    unsigned voffA[2], voffB[2];
#pragma unroll
    for (int i = 0; i < 2; ++i) { int R, C; stage_rc(tid * 16 + i * 8192, R, C);
        voffA[i] = (unsigned)(R * K + C) * 2u; voffB[i] = (unsigned)(tid * 16 + i * 8192); }
    const size_t kstep = (size_t)(BK * 2);
    const size_t hstep = (size_t)HALF * K * 2;
    const size_t tstep = 2 * hstep;
    const size_t kstepB = 32768, hstepB = 16384, tstepB = (size_t)nt * 32768;
    const unsigned ldsw = (unsigned)wid * 1024u;
    const int aoff = lds_byte(wr * 64 + fr, fq * 8), boff = lds_byte(wc * 32 + fr, fq * 8);
#define PG8_SA(b, h) (((b) * 2 + (h)) * HTB)
#define PG8_SB(b, h) ((4 + (b) * 2 + (h)) * HTB)
#define PG8_STAGE(bufoff, gbase, voff) do { _Pragma("unroll") for (int _i = 0; _i < 2; ++_i) \
        __builtin_amdgcn_global_load_lds((const unsigned*)((const char*)(gbase) + (voff)[_i]), (PG8_LAS unsigned*)(lds + (bufoff) + ldsw + _i * 8192), 16, 0, 0); } while (0)
#define PG8_LDA(dst, b, h) do { _Pragma("unroll") for (int m = 0; m < 4; ++m) _Pragma("unroll") for (int k = 0; k < 2; ++k) dst[m][k] = *(const PG8_LAS bf16x8*)(lds + PG8_SA(b, h) + aoff + m * 2048 + k * 1024); } while (0)
#define PG8_LDB(dst, b, h) do { _Pragma("unroll") for (int n = 0; n < 2; ++n) _Pragma("unroll") for (int k = 0; k < 2; ++k) dst[n][k] = *(const PG8_LAS bf16x8*)(lds + PG8_SB(b, h) + boff + n * 2048 + k * 1024); } while (0)
#define PG8_MMA(ai, bj, At, Bt) do { __builtin_amdgcn_s_setprio(1); _Pragma("unroll") for (int m = 0; m < 4; ++m) _Pragma("unroll") for (int n = 0; n < 2; ++n) _Pragma("unroll") for (int k = 0; k < 2; ++k) \
        acc[ai][bj][m][n] = __builtin_amdgcn_mfma_f32_16x16x32_bf16(Bt[n][k], At[m][k], acc[ai][bj][m][n], 0, 0, 0); __builtin_amdgcn_s_setprio(0); } while (0)
#define PG8_WAIT_V(n) asm volatile("s_waitcnt vmcnt(" #n ")" ::: "memory")
#define PG8_WAIT_L(n) asm volatile("s_waitcnt lgkmcnt(" #n ")" ::: "memory")
#define PG8_BAR __builtin_amdgcn_s_barrier()
#define PG8_SCHED __builtin_amdgcn_sched_barrier(0)
    Unit cur, nxt; int ui = 0;
    if (!S.next(0, cur)) return;
    f32x4 acc[2][2][4][2];
#pragma unroll
    for (int a = 0; a < 2; ++a)
#pragma unroll
        for (int b = 0; b < 2; ++b)
#pragma unroll
            for (int m = 0; m < 4; ++m)
#pragma unroll
                for (int n = 0; n < 2; ++n) acc[a][b][m][n] = (f32x4){0.f, 0.f, 0.f, 0.f};
    bf16x8 At[4][2], B0[2][2], B1[2][2];
    const char* cA = (const char*)g.A + (size_t)cur.pm * tstep + (size_t)cur.br * g.strideA; const char* cB = (const char*)g.Bt + (size_t)cur.pn * tstepB + (size_t)cur.br * g.strideB;
    S.a_ready(cur);
    PG8_STAGE(PG8_SB(0, 0), cB, voffB); PG8_STAGE(PG8_SA(0, 0), cA, voffA); PG8_STAGE(PG8_SB(0, 1), cB + hstepB, voffB); PG8_STAGE(PG8_SA(0, 1), cA + hstep, voffA);
    if (wr == 1) PG8_BAR;
    PG8_WAIT_V(4); PG8_BAR;
    PG8_STAGE(PG8_SB(1, 0), cB + kstepB, voffB); PG8_STAGE(PG8_SA(1, 0), cA + kstep, voffA); PG8_STAGE(PG8_SB(1, 1), cB + hstepB + kstepB, voffB);
    PG8_WAIT_V(6); PG8_BAR;
    for (;;) {
        const bool has_next = S.next(ui + 1, nxt);
        const char* nA = has_next ? (const char*)g.A + (size_t)nxt.pm * tstep + (size_t)nxt.br * g.strideA : cA; const char* nB = has_next ? (const char*)g.Bt + (size_t)nxt.pn * tstepB + (size_t)nxt.br * g.strideB : cB;
        for (int t = 0; t < nt; t += 2) {
            const bool last = (t == nt - 2);
            const char* a1 = cA + (size_t)(t + 1) * kstep;
            const char* a2 = last ? nA : cA + (size_t)(t + 2) * kstep; const char* b2 = last ? nB : cB + (size_t)(t + 2) * kstepB;
            const char* a3 = a2 + kstep; const char* b3 = b2 + kstepB;
            if (last && has_next) S.a_ready(nxt);
            PG8_LDB(B0, 0, 0); PG8_SCHED; PG8_LDA(At, 0, 0); PG8_STAGE(PG8_SA(1, 1), a1 + hstep, voffA);
            PG8_WAIT_L(8); PG8_BAR; PG8_WAIT_L(0); PG8_MMA(0, 0, At, B0); PG8_BAR; PG8_SCHED;
            PG8_LDB(B1, 0, 1); PG8_STAGE(PG8_SB(0, 0), b2, voffB);
            PG8_BAR; PG8_WAIT_L(0); PG8_MMA(0, 1, At, B1); PG8_BAR;
            PG8_LDA(At, 0, 1); PG8_STAGE(PG8_SA(0, 0), a2, voffA);
            PG8_BAR; PG8_WAIT_L(0); PG8_MMA(1, 0, At, B0); PG8_BAR; PG8_SCHED;
            PG8_STAGE(PG8_SB(0, 1), b2 + hstepB, voffB);
            PG8_WAIT_V(6); PG8_BAR; PG8_MMA(1, 1, At, B1); PG8_BAR;
            PG8_LDB(B0, 1, 0); PG8_SCHED; PG8_LDA(At, 1, 0); PG8_STAGE(PG8_SA(0, 1), a2 + hstep, voffA);
            PG8_WAIT_L(8); PG8_BAR; PG8_WAIT_L(0); PG8_MMA(0, 0, At, B0); PG8_BAR; PG8_SCHED;
            PG8_LDB(B1, 1, 1); PG8_STAGE(PG8_SB(1, 0), b3, voffB);
            PG8_BAR; PG8_WAIT_L(0); PG8_MMA(0, 1, At, B1); PG8_BAR;
            PG8_LDA(At, 1, 1); PG8_STAGE(PG8_SA(1, 0), a3, voffA);
            PG8_BAR; PG8_WAIT_L(0); PG8_MMA(1, 0, At, B0); PG8_BAR; PG8_SCHED;
            PG8_STAGE(PG8_SB(1, 1), b3 + hstepB, voffB);
            PG8_WAIT_V(6); PG8_BAR; PG8_MMA(1, 1, At, B1); PG8_BAR;
        }
        if constexpr (!Epi::AFTER_DRAIN) { E(acc, cur, wr, wc, fr, fq); if constexpr (Epi::IDEMP && EPI_REP > 1) { asm volatile("" ::: "memory"); E(acc, cur, wr, wc, fr, fq); } S.done(cur); }
        if (!has_next) break;
        if (!(Epi::CHAIN && cur.br < 2))
#pragma unroll
        for (int a = 0; a < 2; ++a)
#pragma unroll
            for (int b = 0; b < 2; ++b)
#pragma unroll
                for (int m = 0; m < 4; ++m)
#pragma unroll
                    for (int n = 0; n < 2; ++n) acc[a][b][m][n] = (f32x4){0.f, 0.f, 0.f, 0.f};
        cur = nxt; cA = nA; cB = nB; ++ui;
    }
    PG8_WAIT_V(0);
    if (wr == 0) PG8_BAR;
    PG8_BAR;
    if constexpr (Epi::AFTER_DRAIN) { E.fused(acc, cur, wr, wc, fr, fq, lds, wid, lane); S.done(cur); }
#undef PG8_SA
#undef PG8_SB
#undef PG8_STAGE
#undef PG8_LDA
#undef PG8_LDB
#undef PG8_MMA
#undef PG8_WAIT_V
#undef PG8_WAIT_L
#undef PG8_BAR
#undef PG8_SCHED
}
}
using pg8::bf16_t; using pg8::f32x4; using pg8::u32x4; using pg8::bf2f; using pg8::bflo; using pg8::bfhi; using pg8::cvt_pk_bf16;

constexpr size_t SZ_FFN_IN = (size_t)2 * DFF * DM * 2, SZ_FFN_OUT = (size_t)DM * DFF * 2, SZ_WIN = (size_t)INW * DM * 2, SZ_SQ = (size_t)DM * DM * 2, SZ_BR = (size_t)3 * DM * 1024 * 2;
constexpr size_t WS_W_FFN1_IN = 0, WS_W_FFN1_OUT = WS_W_FFN1_IN + SZ_FFN_IN, WS_W_WIN = WS_W_FFN1_OUT + SZ_FFN_OUT, WS_W_MEMKV = WS_W_WIN + SZ_WIN, WS_W_BR = WS_W_MEMKV + SZ_SQ,
                 WS_W_WOUT = WS_W_BR + SZ_BR, WS_W_FFN2_IN = WS_W_WOUT + SZ_SQ, WS_W_FFN2_OUT = WS_W_FFN2_IN + SZ_FFN_IN, WS_XN = WS_W_FFN2_OUT + SZ_FFN_OUT,
                 WS_ACT = WS_XN + (size_t)T_TOK * DM * 2, WS_ZG = WS_ACT + (size_t)T_TOK * DFF * 2, WS_OB = WS_ZG + (size_t)T_TOK * ZGW * 2,
                 WS_MEMN = WS_OB + (size_t)3 * T_TOK * 1024 * 2, WS_MKV = WS_MEMN + (size_t)1024 * DM * 2, WS_VT = WS_MKV + (size_t)1024 * DM * 2, WS_WSB = WS_VT + (size_t)16 * 256 * 256 * 2, WS_BAR = WS_WSB + (size_t)4 * 128 * 128 * 2, WS_H16 = WS_BAR + 16384, WS_END = WS_H16 + (size_t)T_TOK * DM * 2;

struct Params { const float* in[20]; float* out; unsigned char* ws; };

__device__ __forceinline__ float wave_sum(float v) {
#pragma unroll
    for (int o = 32; o >= 1; o >>= 1) v += __shfl_xor(v, o);
    return v;
}
__device__ __forceinline__ float wave_max(float v) {
#pragma unroll
    for (int o = 32; o >= 1; o >>= 1) v = fmaxf(v, __shfl_xor(v, o));
    return v;
}

__device__ __forceinline__ void convert_t(const float* __restrict__ W, int K, int N, bf16_t* __restrict__ Wt, int swiglu, int& cursor, float* tile, int perm) {
    int bid_ = blockIdx.x, gdim_ = gridDim.x; asm volatile("" : "+s"(bid_), "+s"(gdim_));
    int tix_ = threadIdx.x; asm volatile("" : "+v"(tix_));
    const int tid = tix_, G = gdim_; const int ntn = N / 256, nt = (K / 64) * ntn;
    const int first = cursor; cursor += nt;
    int id = first + (((int)bid_ - (first % G)) + G) % G;
    const int last = first + nt * CONV_REP;
    float4 v[8];
    if (id < last) { const int tl = (id - first) % nt; const int k0 = (tl / ntn) * 64, n0 = (tl % ntn) * 256;
#pragma unroll
        for (int i = 0; i < 8; ++i) { const int idx = tid + 512 * i; const int row = idx >> 6, c4 = idx & 63; v[i] = *(const float4*)(W + (size_t)(k0 + row) * N + n0 + 4 * c4); } }
    for (; id < last; id += G) {
        const int tl = (id - first) % nt; const int k0 = (tl / ntn) * 64, n0 = (tl % ntn) * 256;
#pragma unroll
        for (int i = 0; i < 8; ++i) { const int idx = tid + 512 * i; const int row = idx >> 6, c4 = idx & 63; float* d = tile + row * 257 + 4 * c4; d[0] = v[i].x; d[1] = v[i].y; d[2] = v[i].z; d[3] = v[i].w; }
        __syncthreads();
        if (id + G < last) { const int tl2 = (id + G - first) % nt; const int k2 = (tl2 / ntn) * 64, n2 = (tl2 % ntn) * 256;
#pragma unroll
            for (int i = 0; i < 8; ++i) { const int idx = tid + 512 * i; const int row = idx >> 6, c4 = idx & 63; v[i] = *(const float4*)(W + (size_t)(k2 + row) * N + n2 + 4 * c4); } }
#pragma unroll
        for (int p = 0; p < 4; ++p) { const int nl = (tid >> 3) + 64 * p, kq = tid & 7; const float* s = tile + (8 * kq) * 257 + nl;
            u32x4 w; w.x = cvt_pk_bf16(s[0], s[257]); w.y = cvt_pk_bf16(s[2 * 257], s[3 * 257]); w.z = cvt_pk_bf16(s[4 * 257], s[5 * 257]); w.w = cvt_pk_bf16(s[6 * 257], s[7 * 257]);
            int n = n0 + nl; if (swiglu) { const int half = n >= DFF ? 1 : 0; const int c = n - half * DFF; n = (c >> 7) * 256 + half * 128 + (c & 127); }
            { const int pn = n >> 8, half = (n >> 7) & 1, r = n & 127, c5 = r & 31;
              const int R = perm ? ((r & ~31) + 16 * ((c5 >> 2) & 1) + 4 * (c5 >> 3) + (c5 & 3)) : r;
              *(u32x4*)((unsigned char*)Wt + ((size_t)pn * (K >> 6) + (k0 >> 6)) * 32768 + half * 16384 + pg8::lds_byte(R, 8 * kq)) = w; } }
        __syncthreads();
    }
}

template <bool F32OUT> __device__ __forceinline__ void norm_rows(const float* X, const float* __restrict__ g, void* out, int rows) {
    int bid_ = blockIdx.x, gdim_ = gridDim.x; asm volatile("" : "+s"(bid_), "+s"(gdim_));
    int tix_ = threadIdx.x; asm volatile("" : "+v"(tix_));
    constexpr int NREP = F32OUT ? 1 : NORM_REP;
    const int lane = tix_ & 63, gw = __builtin_amdgcn_readfirstlane(bid_ * 8 + (tix_ >> 6)), GW = gdim_ * 8;
    float4 gv[8];
#pragma unroll
    for (int i = 0; i < 8; ++i) gv[i] = *(const float4*)(g + 4 * lane + 256 * i);
    int row = gw; float4 x[8];
    if (row < rows * NREP) {
#pragma unroll
        for (int i = 0; i < 8; ++i) x[i] = *(const float4*)(X + (size_t)(NREP > 1 ? row % rows : row) * DM + 4 * lane + 256 * i); }
    while (row < rows * NREP) {
        const int nrow = row + GW; float4 xn[8];
        if (nrow < rows * NREP) {
#pragma unroll
            for (int i = 0; i < 8; ++i) xn[i] = *(const float4*)(X + (size_t)(NREP > 1 ? nrow % rows : nrow) * DM + 4 * lane + 256 * i); }
        float ss = 0.f;
#pragma unroll
        for (int i = 0; i < 8; ++i) ss += x[i].x * x[i].x + x[i].y * x[i].y + x[i].z * x[i].z + x[i].w * x[i].w;
        ss = wave_sum(ss);
        const float rstd = rsqrtf(ss * (1.0f / DM) + 1e-6f);
#pragma unroll
        for (int i = 0; i < 8; ++i) {
            const float a = x[i].x * rstd * gv[i].x, b = x[i].y * rstd * gv[i].y, c = x[i].z * rstd * gv[i].z, d = x[i].w * rstd * gv[i].w;
            if (F32OUT) *(float4*)((float*)out + (size_t)(NREP > 1 ? row % rows : row) * DM + 4 * lane + 256 * i) = make_float4(a, b, c, d);
            else { uint2 w; w.x = cvt_pk_bf16(a, b); w.y = cvt_pk_bf16(c, d); *(uint2*)((bf16_t*)out + (size_t)(NREP > 1 ? row % rows : row) * DM + 4 * lane + 256 * i) = w; }
        }
#pragma unroll
        for (int i = 0; i < 8; ++i) x[i] = xn[i];
        row = nrow;
    }
}

template <bool F32OUT> __device__ __forceinline__ void norm_rows16(const bf16_t* X, const float* __restrict__ g, void* out, int rows) {
    int bid_ = blockIdx.x, gdim_ = gridDim.x; asm volatile("" : "+s"(bid_), "+s"(gdim_));
    int tix_ = threadIdx.x; asm volatile("" : "+v"(tix_));
    const int lane = tix_ & 63, gw = __builtin_amdgcn_readfirstlane(bid_ * 8 + (tix_ >> 6)), GW = gdim_ * 8;
    float4 ga[4], gb[4];
#pragma unroll
    for (int i = 0; i < 4; ++i) { ga[i] = *(const float4*)(g + 8 * lane + 512 * i); gb[i] = *(const float4*)(g + 8 * lane + 512 * i + 4); }
    int row = gw; u32x4 x[4];
    if (row < rows) {
#pragma unroll
        for (int i = 0; i < 4; ++i) x[i] = *(const u32x4*)(X + (size_t)row * DM + 8 * lane + 512 * i); }
    while (row < rows) {
        const int nrow = row + GW; u32x4 xn[4];
        if (nrow < rows) {
#pragma unroll
            for (int i = 0; i < 4; ++i) xn[i] = *(const u32x4*)(X + (size_t)nrow * DM + 8 * lane + 512 * i); }
        float v[4][8]; float ss = 0.f;
#pragma unroll
        for (int i = 0; i < 4; ++i) { v[i][0] = bflo(x[i].x); v[i][1] = bfhi(x[i].x); v[i][2] = bflo(x[i].y); v[i][3] = bfhi(x[i].y); v[i][4] = bflo(x[i].z); v[i][5] = bfhi(x[i].z); v[i][6] = bflo(x[i].w); v[i][7] = bfhi(x[i].w);
#pragma unroll
            for (int e = 0; e < 8; ++e) ss += v[i][e] * v[i][e]; }
        ss = wave_sum(ss);
        const float rstd = rsqrtf(ss * (1.0f / DM) + 1e-6f);
#pragma unroll
        for (int i = 0; i < 4; ++i) {
            const float o0 = v[i][0] * rstd * ga[i].x, o1 = v[i][1] * rstd * ga[i].y, o2 = v[i][2] * rstd * ga[i].z, o3 = v[i][3] * rstd * ga[i].w;
            const float o4 = v[i][4] * rstd * gb[i].x, o5 = v[i][5] * rstd * gb[i].y, o6 = v[i][6] * rstd * gb[i].z, o7 = v[i][7] * rstd * gb[i].w;
            if (F32OUT) { float* op = (float*)out + (size_t)row * DM + 8 * lane + 512 * i; __builtin_nontemporal_store((f32x4){o0, o1, o2, o3}, (f32x4*)op); __builtin_nontemporal_store((f32x4){o4, o5, o6, o7}, (f32x4*)(op + 4)); }
            else { u32x4 w; w.x = cvt_pk_bf16(o0, o1); w.y = cvt_pk_bf16(o2, o3); w.z = cvt_pk_bf16(o4, o5); w.w = cvt_pk_bf16(o6, o7); *(u32x4*)((bf16_t*)out + (size_t)row * DM + 8 * lane + 512 * i) = w; }
        }
#pragma unroll
        for (int i = 0; i < 4; ++i) x[i] = xn[i];
        row = nrow;
    }
}

__device__ __forceinline__ void mixC_naive(const bf16_t* __restrict__ ZA, const bf16_t* __restrict__ MKV, bf16_t* __restrict__ OC) {
    const int lane = threadIdx.x & 63, gw = __builtin_amdgcn_readfirstlane(blockIdx.x * 8 + (threadIdx.x >> 6)), GW = gridDim.x * 8;
    for (int task = gw; task < T_TOK * 4; task += GW) {
        const int tok = task >> 2, h = task & 3, b = tok >> 12;
        const uint2 qv = *(const uint2*)(ZA + (size_t)tok * ZAW + ZMQ + h * 256 + lane * 4);
        const float q0 = bflo(qv.x), q1 = bfhi(qv.x), q2 = bflo(qv.y), q3 = bfhi(qv.y);
        const bf16_t* kb = MKV + (size_t)(b * 256) * DM + h * 256 + lane * 4;
        float sc[4];
#pragma unroll
        for (int i = 0; i < 4; ++i) { sc[i] = 0.f;
            for (int mm = 0; mm < 64; ++mm) { const uint2 kv = *(const uint2*)(kb + (size_t)(i * 64 + mm) * DM);
                float s = q0 * bflo(kv.x) + q1 * bfhi(kv.x) + q2 * bflo(kv.y) + q3 * bfhi(kv.y); s = wave_sum(s); sc[i] = (lane == mm) ? s : sc[i]; } }
        float mx = fmaxf(fmaxf(sc[0], sc[1]), fmaxf(sc[2], sc[3])); mx = wave_max(mx);
        float ps = 0.f;
#pragma unroll
        for (int i = 0; i < 4; ++i) { sc[i] = __expf((sc[i] - mx) * 0.0625f); ps += sc[i]; }
        ps = wave_sum(ps); const float inv = 1.0f / ps;
        float o0 = 0.f, o1 = 0.f, o2 = 0.f, o3 = 0.f;
#pragma unroll
        for (int i = 0; i < 4; ++i)
            for (int mm = 0; mm < 64; ++mm) { const float pm = __shfl(sc[i], mm); const uint2 vv = *(const uint2*)(kb + (size_t)(i * 64 + mm) * DM + 1024);
                o0 += pm * bflo(vv.x); o1 += pm * bfhi(vv.x); o2 += pm * bflo(vv.y); o3 += pm * bfhi(vv.y); }
        uint2 w; w.x = cvt_pk_bf16(o0 * inv, o1 * inv); w.y = cvt_pk_bf16(o2 * inv, o3 * inv);
        *(uint2*)(OC + (size_t)tok * 1024 + h * 256 + lane * 4) = w;
    }
}
__device__ __forceinline__ void mixB_naive(const bf16_t* __restrict__ ZA, const float* __restrict__ sinks, bf16_t* __restrict__ OBo) {
    const int lane = threadIdx.x & 63, gw = __builtin_amdgcn_readfirstlane(blockIdx.x * 8 + (threadIdx.x >> 6)), GW = gridDim.x * 8;
    const int r = lane >> 4, i4 = lane & 15;
    for (int task = gw; task < T_TOK * 4; task += GW) {
        const int tok = task >> 2, hk = task & 3, pos = tok & (SEQ - 1), h = hk * 4 + r;
        const uint2 qv = *(const uint2*)(ZA + (size_t)tok * ZAW + ZQ + h * 64 + i4 * 4);
        const float q0 = bflo(qv.x), q1 = bfhi(qv.x), q2 = bflo(qv.y), q3 = bfhi(qv.y);
        const float slope = exp2f(-0.5f * (float)(h + 1)), sink = sinks[h];
        const bf16_t* kb = ZA + (size_t)tok * ZAW + ZK + hk * 64 + i4 * 4;
        float sc[8];
#pragma unroll
        for (int jb = 0; jb < 8; ++jb) { sc[jb] = -1e30f;
#pragma unroll 2
            for (int kk = 0; kk < 16; ++kk) { const int dist = jb * 16 + kk; const bool valid = dist <= pos; const int dd = valid ? dist : 0;
                const uint2 kv = *(const uint2*)(kb - (size_t)dd * ZAW);
                float s = q0 * bflo(kv.x) + q1 * bfhi(kv.x) + q2 * bflo(kv.y) + q3 * bfhi(kv.y);
                s += __shfl_xor(s, 1); s += __shfl_xor(s, 2); s += __shfl_xor(s, 4); s += __shfl_xor(s, 8);
                s = valid ? (s * 0.125f - slope * (float)dist) : -1e30f; sc[jb] = (i4 == kk) ? s : sc[jb]; } }
        float mx = sc[0];
#pragma unroll
        for (int jb = 1; jb < 8; ++jb) mx = fmaxf(mx, sc[jb]);
        mx = fmaxf(mx, __shfl_xor(mx, 1)); mx = fmaxf(mx, __shfl_xor(mx, 2)); mx = fmaxf(mx, __shfl_xor(mx, 4)); mx = fmaxf(mx, __shfl_xor(mx, 8));
        mx = fmaxf(mx, sink);
        float ps = 0.f;
#pragma unroll
        for (int jb = 0; jb < 8; ++jb) { sc[jb] = __expf(sc[jb] - mx); ps += sc[jb]; }
        ps += __shfl_xor(ps, 1); ps += __shfl_xor(ps, 2); ps += __shfl_xor(ps, 4); ps += __shfl_xor(ps, 8);
        const float inv = 1.0f / (ps + __expf(sink - mx));
        float o0 = 0.f, o1 = 0.f, o2 = 0.f, o3 = 0.f;
#pragma unroll
        for (int jb = 0; jb < 8; ++jb) {
#pragma unroll 2
            for (int kk = 0; kk < 16; ++kk) { const int dist = jb * 16 + kk; const float pm = __shfl(sc[jb], (lane & 48) | kk); const int dd = dist <= pos ? dist : 0;
                const uint2 vv = *(const uint2*)(kb - (size_t)dd * ZAW + (ZVV - ZK));
                o0 += pm * bflo(vv.x); o1 += pm * bfhi(vv.x); o2 += pm * bflo(vv.y); o3 += pm * bfhi(vv.y); } }
        uint2 w; w.x = cvt_pk_bf16(o0 * inv, o1 * inv); w.y = cvt_pk_bf16(o2 * inv, o3 * inv);
        *(uint2*)(OBo + (size_t)tok * 1024 + h * 64 + i4 * 4) = w;
    }
}
__device__ __forceinline__ void mixA_naive(const bf16_t* __restrict__ ZA, const float* __restrict__ lng, const float* __restrict__ lnb, const float* __restrict__ ws_, const float* __restrict__ bs_, bf16_t* __restrict__ OA, unsigned char* shm) {
    float* st = (float*)shm;
    bf16_t* vn = (bf16_t*)(shm + 1024);
    const int tid = threadIdx.x, lane = tid & 63, wid = __builtin_amdgcn_readfirstlane(tid >> 6);
    for (int task = blockIdx.x; task < 512; task += gridDim.x) {
        const int c = task >> 2, g = task & 3, tok0 = c * 128;
#pragma unroll 1
        for (int jb = 0; jb < 4; ++jb) { u32x4 av[4], bv[4];
#pragma unroll
            for (int jj = 0; jj < 4; ++jj) { const bf16_t* vp = ZA + (size_t)(tok0 + 16 * wid + 4 * jb + jj) * ZAW + ZV + lane * 16; av[jj] = *(const u32x4*)vp; bv[jj] = *(const u32x4*)(vp + 8); }
#pragma unroll
            for (int jj = 0; jj < 4; ++jj) { const int s = 16 * wid + 4 * jb + jj; const u32x4 a = av[jj], b2 = bv[jj]; float x[16];
                x[0] = bflo(a.x); x[1] = bfhi(a.x); x[2] = bflo(a.y); x[3] = bfhi(a.y); x[4] = bflo(a.z); x[5] = bfhi(a.z); x[6] = bflo(a.w); x[7] = bfhi(a.w);
                x[8] = bflo(b2.x); x[9] = bfhi(b2.x); x[10] = bflo(b2.y); x[11] = bfhi(b2.y); x[12] = bflo(b2.z); x[13] = bfhi(b2.z); x[14] = bflo(b2.w); x[15] = bfhi(b2.w);
                float sm = 0.f;
#pragma unroll
                for (int e = 0; e < 16; ++e) sm += x[e];
                sm = wave_sum(sm); const float mu = sm * (1.0f / 1024.0f); float sq = 0.f;
#pragma unroll
                for (int e = 0; e < 16; ++e) { const float d = x[e] - mu; sq += d * d; }
                sq = wave_sum(sq); const float rstd = rsqrtf(sq * (1.0f / 1024.0f) + 1e-6f);
                if (lane == 0) { st[2 * s] = mu; st[2 * s + 1] = rstd; } } }
        __syncthreads();
        const int d = tid & 255, th = __builtin_amdgcn_readfirstlane(tid >> 8);
        { const float gg = lng[g * 256 + d], bb = lnb[g * 256 + d];
          for (int s = th * 64; s < th * 64 + 64; ++s) { const float v = bf2f(ZA[(size_t)(tok0 + s) * ZAW + ZV + g * 256 + d]);
              const float y = (v - st[2 * s]) * st[2 * s + 1] * gg + bb; vn[s * 256 + d] = (bf16_t)(cvt_pk_bf16(y, 0.f) & 0xffffu); } }
        __syncthreads();
        for (int t = th * 64; t < th * 64 + 64; ++t) { const float* wr_ = ws_ + (size_t)(g * 128 + t) * 128; float acc = 0.f;
#pragma unroll 4
            for (int s = 0; s <= t; ++s) acc += wr_[s] * bf2f(vn[s * 256 + d]);
            const float mixed = acc + bs_[g * 128 + t]; const float uu = bf2f(ZA[(size_t)(tok0 + t) * ZAW + ZU + g * 256 + d]);
            OA[(size_t)(tok0 + t) * 1024 + g * 256 + d] = (bf16_t)(cvt_pk_bf16(uu * mixed, 0.f) & 0xffffu); }
        __syncthreads();
    }
}


typedef short s16x4 __attribute__((ext_vector_type(4)));
using pg8::bf16x8;
__device__ __forceinline__ bf16x8 pack8(const f32x4& a, const f32x4& b) {
    u32x4 w; w.x = cvt_pk_bf16(a[0], a[1]); w.y = cvt_pk_bf16(a[2], a[3]); w.z = cvt_pk_bf16(b[0], b[1]); w.w = cvt_pk_bf16(b[2], b[3]); return __builtin_bit_cast(bf16x8, w);
}
__device__ __forceinline__ bf16x8 cat44(const s16x4& a, const s16x4& b) { return (bf16x8){a[0], a[1], a[2], a[3], b[0], b[1], b[2], b[3]}; }
__device__ __forceinline__ s16x4 tr_read(const unsigned char* p) { return __builtin_amdgcn_ds_read_tr16_b64_v4i16((PG8_LAS s16x4*)p); }
#define MFMA16(a, b, c) __builtin_amdgcn_mfma_f32_16x16x32_bf16((a), (b), (c), 0, 0, 0)

__device__ __forceinline__ void mixC_mfma(const bf16_t* __restrict__ ZA, const bf16_t* __restrict__ MK, const bf16_t* __restrict__ VT, bf16_t* __restrict__ OC) {
    int tix_ = threadIdx.x; asm volatile("" : "+v"(tix_));
    int bid_ = blockIdx.x, gdim_ = gridDim.x; asm volatile("" : "+s"(bid_), "+s"(gdim_));
    const int lane = tix_ & 63, i = lane & 15, g = lane >> 4;
    const int gw = __builtin_amdgcn_readfirstlane(bid_ * 8 + (tix_ >> 6)), GW = gdim_ * 8;
    for (int task_ = gw; task_ < (T_TOK / 16) * 4 * MIXC_REP; task_ += GW) { const int task = task_ % ((T_TOK / 16) * 4);
        const int h = task & 3, t0 = (task >> 2) * 16, b = t0 >> 12;
        f32x4 s[16];
#pragma unroll
        for (int mt = 0; mt < 16; ++mt) s[mt] = (f32x4){0.f, 0.f, 0.f, 0.f};
        const bf16_t* qp = ZA + (size_t)(t0 + i) * ZAW + ZMQ + h * 256 + 8 * g;
        const bf16_t* kp = MK + (size_t)(b * 256 + i) * DM + h * 256 + 8 * g;
#pragma unroll
        for (int ks = 0; ks < 8; ++ks) { const bf16x8 qf = *(const bf16x8*)(qp + 32 * ks);
#pragma unroll
            for (int mt = 0; mt < 16; ++mt) { const bf16x8 kf = *(const bf16x8*)(kp + (size_t)(16 * mt) * DM + 32 * ks); s[mt] = MFMA16(kf, qf, s[mt]); } }
        float mx = -3.0e38f;
#pragma unroll
        for (int mt = 0; mt < 16; ++mt) mx = fmaxf(fmaxf(fmaxf(s[mt][0], s[mt][1]), fmaxf(s[mt][2], s[mt][3])), mx);
        mx = fmaxf(mx, __shfl_xor(mx, 16)); mx = fmaxf(mx, __shfl_xor(mx, 32));
        float sum = 0.f;
#pragma unroll
        for (int mt = 0; mt < 16; ++mt)
#pragma unroll
            for (int r = 0; r < 4; ++r) { const float e = __expf((s[mt][r] - mx) * 0.0625f); s[mt][r] = e; sum += e; }
        sum += __shfl_xor(sum, 16); sum += __shfl_xor(sum, 32);
        const float inv = 1.0f / sum;
        bf16x8 pf[8];
#pragma unroll
        for (int ks = 0; ks < 8; ++ks) pf[ks] = pack8(s[2 * ks], s[2 * ks + 1]);
        const bf16_t* vp = VT + (size_t)((b * 4 + h) * 256 + i) * 256 + 4 * g;
        bf16_t* op = OC + (size_t)(t0 + i) * 1024 + h * 256 + 4 * g;
#pragma unroll 4
        for (int dt = 0; dt < 16; ++dt) { f32x4 o = (f32x4){0.f, 0.f, 0.f, 0.f};
#pragma unroll
            for (int ks = 0; ks < 8; ++ks) { const s16x4 lo = *(const s16x4*)(vp + (size_t)(16 * dt) * 256 + 32 * ks), hi = *(const s16x4*)(vp + (size_t)(16 * dt) * 256 + 32 * ks + 16);
                o = MFMA16(cat44(lo, hi), pf[ks], o); }
            uint2 w; w.x = cvt_pk_bf16(o[0] * inv, o[1] * inv); w.y = cvt_pk_bf16(o[2] * inv, o[3] * inv); *(uint2*)(op + 16 * dt) = w; }
    }
}


__device__ __forceinline__ void mixC_lds(const bf16_t* __restrict__ ZA, const bf16_t* __restrict__ MK, const bf16_t* __restrict__ VT, bf16_t* __restrict__ OC, unsigned char* shm) {
    int bid_ = blockIdx.x, gdim_ = gridDim.x; asm volatile("" : "+s"(bid_), "+s"(gdim_));
    int tix_ = threadIdx.x; asm volatile("" : "+v"(tix_));
    constexpr int RS = 528;
    const int tid = tix_, lane = tid & 63, w = __builtin_amdgcn_readfirstlane(tid >> 6), i = lane & 15, g = lane >> 4;
    for (int task = bid_; task < 256; task += gdim_) {
        const int chunk = task & 15, h = (task >> 4) & 3, b = task >> 6;
        const int tokbase = b * SEQ + chunk * 256 + 32 * w;
        f32x4 s[2][16];
#pragma unroll
        for (int mt = 0; mt < 16; ++mt) { s[0][mt] = (f32x4){0.f, 0.f, 0.f, 0.f}; s[1][mt] = (f32x4){0.f, 0.f, 0.f, 0.f}; }
        const bf16_t* qp = ZA + (size_t)(tokbase + i) * ZAW + ZMQ + h * 256 + 8 * g;
        bf16x8 qf[2][8];
#pragma unroll
        for (int ks = 0; ks < 8; ++ks) { qf[0][ks] = *(const bf16x8*)(qp + 32 * ks); qf[1][ks] = *(const bf16x8*)(qp + (size_t)16 * ZAW + 32 * ks); }
#pragma unroll
        for (int p = 0; p < 2; ++p) {
            __syncthreads();
#pragma unroll
            for (int it = 0; it < 8; ++it) { const int item = tid + 512 * it; const int ch = item & 31, r = item >> 5;
                const u32x4 v = *(const u32x4*)(MK + (size_t)(b * 256 + 128 * p + r) * DM + h * 256 + 8 * ch); *(u32x4*)(shm + r * RS + ch * 16) = v; }
            __syncthreads();
#pragma unroll
            for (int ks = 0; ks < 8; ++ks) { const bf16x8 q0 = qf[0][ks], q1 = qf[1][ks];
#pragma unroll
                for (int mt = 0; mt < 8; ++mt) { const bf16x8 kf = *(const bf16x8*)(shm + (16 * mt + i) * RS + (32 * ks + 8 * g) * 2);
                    s[0][8 * p + mt] = MFMA16(kf, q0, s[0][8 * p + mt]); s[1][8 * p + mt] = MFMA16(kf, q1, s[1][8 * p + mt]); } }
        }
        bf16x8 pf[2][8]; float inv[2];
#pragma unroll
        for (int qt = 0; qt < 2; ++qt) {
            float mx = -3.0e38f;
#pragma unroll
            for (int mt = 0; mt < 16; ++mt) mx = fmaxf(fmaxf(fmaxf(s[qt][mt][0], s[qt][mt][1]), fmaxf(s[qt][mt][2], s[qt][mt][3])), mx);
            mx = fmaxf(mx, __shfl_xor(mx, 16)); mx = fmaxf(mx, __shfl_xor(mx, 32));
            float sum = 0.f;
#pragma unroll
            for (int mt = 0; mt < 16; ++mt)
#pragma unroll
                for (int r = 0; r < 4; ++r) { const float e = __expf((s[qt][mt][r] - mx) * 0.0625f); s[qt][mt][r] = e; sum += e; }
            sum += __shfl_xor(sum, 16); sum += __shfl_xor(sum, 32);
            inv[qt] = 1.0f / sum;
#pragma unroll
            for (int ks = 0; ks < 8; ++ks) pf[qt][ks] = pack8(s[qt][2 * ks], s[qt][2 * ks + 1]);
        }
        bf16_t* op = OC + (size_t)(tokbase + i) * 1024 + h * 256 + 4 * g;
#pragma unroll
        for (int p = 0; p < 2; ++p) {
            __syncthreads();
#pragma unroll
            for (int it = 0; it < 8; ++it) { const int item = tid + 512 * it; const int ch = item & 31, r = item >> 5;
                const u32x4 v = *(const u32x4*)(VT + (size_t)((b * 4 + h) * 256 + 128 * p + r) * 256 + 8 * ch); *(u32x4*)(shm + r * RS + ch * 16) = v; }
            __syncthreads();
#pragma unroll 2
            for (int dt = 0; dt < 8; ++dt) { f32x4 o0 = (f32x4){0.f, 0.f, 0.f, 0.f}, o1 = (f32x4){0.f, 0.f, 0.f, 0.f};
#pragma unroll
                for (int ks = 0; ks < 8; ++ks) { const unsigned char* vp = shm + (16 * dt + i) * RS + (32 * ks + 4 * g) * 2;
                    const bf16x8 vf = cat44(*(const s16x4*)vp, *(const s16x4*)(vp + 32));
                    o0 = MFMA16(vf, pf[0][ks], o0); o1 = MFMA16(vf, pf[1][ks], o1); }
                uint2 w0; w0.x = cvt_pk_bf16(o0[0] * inv[0], o0[1] * inv[0]); w0.y = cvt_pk_bf16(o0[2] * inv[0], o0[3] * inv[0]); *(uint2*)(op + 128 * p + 16 * dt) = w0;
                uint2 w1; w1.x = cvt_pk_bf16(o1[0] * inv[1], o1[1] * inv[1]); w1.y = cvt_pk_bf16(o1[2] * inv[1], o1[3] * inv[1]); *(uint2*)(op + (size_t)16 * 1024 + 128 * p + 16 * dt) = w1; }
        }
    }
}

__device__ __forceinline__ void mixB_mfma(const bf16_t* __restrict__ ZA, const float* __restrict__ sinks, bf16_t* __restrict__ OBo, unsigned char* shm) {
    int tix_ = threadIdx.x; asm volatile("" : "+v"(tix_));
    int bid_ = blockIdx.x, gdim_ = gridDim.x; asm volatile("" : "+s"(bid_), "+s"(gdim_));
    constexpr int RS = 144;
    unsigned char* Kl = shm; unsigned char* Vl = shm + 256 * RS;
    const int tid = tix_, lane = tid & 63, w = __builtin_amdgcn_readfirstlane(tid >> 6), i = lane & 15, g = lane >> 4;
    for (int task_ = bid_; task_ < 512 * MIXB_REP; task_ += gdim_) { const int task = task_ & 511;
        const int hk = task & 3, cb = (task >> 2) & 31, b = task >> 7; const int tokblk = b * SEQ + cb * 128;
#pragma unroll
        for (int it = 0; it < 8; ++it) { const int item = tid + 512 * it; const int ch = item & 7, kl = (item >> 3) & 255, which = item >> 11;
            const bool ok = (cb > 0) || (kl >= 128); const int tok = ok ? (tokblk - 128 + kl) : tokblk;
            u32x4 v = *(const u32x4*)(ZA + (size_t)tok * ZAW + (which ? ZVV : ZK) + hk * 64 + 8 * ch);
            if (!ok) v = (u32x4){0u, 0u, 0u, 0u};
            *(u32x4*)((which ? Vl : Kl) + kl * RS + ch * 16) = v; }
        __syncthreads();
        const int t0 = tokblk + 16 * w;
        bf16x8 qall[4][2];
#pragma unroll
        for (int r = 0; r < 4; ++r) { const bf16_t* qp = ZA + (size_t)(t0 + i) * ZAW + ZQ + (hk * 4 + r) * 64 + 8 * g; qall[r][0] = *(const bf16x8*)qp; qall[r][1] = *(const bf16x8*)(qp + 32); }
#pragma unroll
        for (int r = 0; r < 4; ++r) { const int h = hk * 4 + r; int il = i; asm volatile("" : "+v"(il));
            const float slope = exp2f(-0.5f * (float)(h + 1)), sink = sinks[h];
            const int dmax = min(127, 16 * w + 128 + il - (cb > 0 ? 0 : 128));
            const bf16x8 qf0 = qall[r][0], qf1 = qall[r][1];
            f32x4 s[10];
            s[0] = (f32x4){0.f, 0.f, 0.f, 0.f};
#pragma unroll
            for (int kt = 1; kt < 10; ++kt) { const int ktl = w - 1 + kt; const unsigned char* kr = Kl + (16 * ktl + i) * RS + 16 * g;
                f32x4 a = (f32x4){0.f, 0.f, 0.f, 0.f};
                a = MFMA16(*(const bf16x8*)kr, qf0, a); a = MFMA16(*(const bf16x8*)(kr + 64), qf1, a);
#pragma unroll
                for (int rr = 0; rr < 4; ++rr) { const int dist = 144 + il - 16 * kt - 4 * g - rr;
                    const bool valid = (unsigned)dist <= (unsigned)dmax;
                    a[rr] = valid ? (a[rr] * 0.125f - slope * (float)dist) : -1e30f; }
                s[kt] = a; }
            float mx = sink;
#pragma unroll
            for (int kt = 1; kt < 10; ++kt) mx = fmaxf(fmaxf(fmaxf(s[kt][0], s[kt][1]), fmaxf(s[kt][2], s[kt][3])), mx);
            mx = fmaxf(mx, __shfl_xor(mx, 16)); mx = fmaxf(mx, __shfl_xor(mx, 32));
            float sum = 0.f;
#pragma unroll
            for (int kt = 1; kt < 10; ++kt)
#pragma unroll
                for (int rr = 0; rr < 4; ++rr) { const float e = __expf(s[kt][rr] - mx); s[kt][rr] = e; sum += e; }
            sum += __shfl_xor(sum, 16); sum += __shfl_xor(sum, 32);
            const float inv = 1.0f / (sum + __expf(sink - mx));
            bf16x8 pf[5];
#pragma unroll
            for (int k5 = 0; k5 < 5; ++k5) pf[k5] = pack8(s[2 * k5], s[2 * k5 + 1]);
            bf16_t* op = OBo + (size_t)(t0 + i) * 1024 + h * 64 + 4 * g;
#pragma unroll
            for (int dt = 0; dt < 4; ++dt) { f32x4 o = (f32x4){0.f, 0.f, 0.f, 0.f};
#pragma unroll
                for (int k5 = 0; k5 < 5; ++k5) { int kt0 = w - 1 + 2 * k5; const int kt1 = kt0 + 1; kt0 = kt0 < 0 ? 0 : kt0;
                    const s16x4 lo = tr_read(Vl + (16 * kt0 + 4 * g + (i >> 2)) * RS + (16 * dt + 4 * (i & 3)) * 2);
                    const s16x4 hi = tr_read(Vl + (16 * kt1 + 4 * g + (i >> 2)) * RS + (16 * dt + 4 * (i & 3)) * 2);
                    o = MFMA16(cat44(lo, hi), pf[k5], o); }
                uint2 wv; wv.x = cvt_pk_bf16(o[0] * inv, o[1] * inv); wv.y = cvt_pk_bf16(o[2] * inv, o[3] * inv); *(uint2*)(op + 16 * dt) = wv; }
        }
        __syncthreads();
    }
}

__device__ __forceinline__ void mixA_mfma(const bf16_t* __restrict__ ZA, const float* __restrict__ lng, const float* __restrict__ lnb, const bf16_t* __restrict__ WSB, const float* __restrict__ bs_, bf16_t* __restrict__ OA, unsigned char* shm) {
    int bid_ = blockIdx.x, gdim_ = gridDim.x; asm volatile("" : "+s"(bid_), "+s"(gdim_));
    int tix_ = threadIdx.x; asm volatile("" : "+v"(tix_));
    constexpr int RS = 528;
    float* st = (float*)shm; unsigned char* vn = shm + 1024; constexpr int WRS = 272; unsigned char* wl = shm + 1024 + 128 * RS;
    const int tid = tix_, lane = tid & 63, wid = __builtin_amdgcn_readfirstlane(tid >> 6), i = lane & 15, g4 = lane >> 4;
    for (int task_ = bid_; task_ < 256 * MIXA_REP; task_ += gdim_) { const int task = task_ & 255;
        const int c = task >> 1, gp = task & 1, tok0 = c * 128;
        __syncthreads();
#pragma unroll 1
        for (int jb = 0; jb < 4; ++jb) { u32x4 av[4], bv[4];
#pragma unroll
            for (int jj = 0; jj < 4; ++jj) { const bf16_t* vp = ZA + (size_t)(tok0 + 16 * wid + 4 * jb + jj) * ZAW + ZV + lane * 16; av[jj] = *(const u32x4*)vp; bv[jj] = *(const u32x4*)(vp + 8); }
#pragma unroll
            for (int jj = 0; jj < 4; ++jj) { const int s = 16 * wid + 4 * jb + jj; const u32x4 a = av[jj], b2 = bv[jj]; float x[16];
                x[0] = bflo(a.x); x[1] = bfhi(a.x); x[2] = bflo(a.y); x[3] = bfhi(a.y); x[4] = bflo(a.z); x[5] = bfhi(a.z); x[6] = bflo(a.w); x[7] = bfhi(a.w);
                x[8] = bflo(b2.x); x[9] = bfhi(b2.x); x[10] = bflo(b2.y); x[11] = bfhi(b2.y); x[12] = bflo(b2.z); x[13] = bfhi(b2.z); x[14] = bflo(b2.w); x[15] = bfhi(b2.w);
                float sm = 0.f;
#pragma unroll
                for (int e = 0; e < 16; ++e) sm += x[e];
                sm = wave_sum(sm); const float mu = sm * (1.0f / 1024.0f); float sq = 0.f;
#pragma unroll
                for (int e = 0; e < 16; ++e) { const float d = x[e] - mu; sq += d * d; }
                sq = wave_sum(sq); const float rstd = rsqrtf(sq * (1.0f / 1024.0f) + 1e-6f);
                if (lane == 0) { st[2 * s] = mu; st[2 * s + 1] = rstd; } } }
#pragma unroll 1
        for (int gi = 0; gi < 2; ++gi) { const int grp = 2 * gp + gi;
            __syncthreads();
#pragma unroll
            for (int it = 0; it < 4; ++it) { const int idx = tid + 512 * it; const int row = idx >> 4, ch = idx & 15;
                *(u32x4*)(wl + row * WRS + ch * 16) = *(const u32x4*)(WSB + (size_t)grp * 16384 + row * 128 + ch * 8); }
            { const int dg = tid & 31; const float4 ga = *(const float4*)(lng + grp * 256 + 8 * dg), gb = *(const float4*)(lng + grp * 256 + 8 * dg + 4), ba = *(const float4*)(lnb + grp * 256 + 8 * dg), bb = *(const float4*)(lnb + grp * 256 + 8 * dg + 4);
#pragma unroll
              for (int it = 0; it < 8; ++it) { const int s = (tid >> 5) + 16 * it; const float mu = st[2 * s], rs = st[2 * s + 1];
                  const u32x4 v = *(const u32x4*)(ZA + (size_t)(tok0 + s) * ZAW + ZV + grp * 256 + 8 * dg);
                  u32x4 wv;
                  wv.x = cvt_pk_bf16((bflo(v.x) - mu) * rs * ga.x + ba.x, (bfhi(v.x) - mu) * rs * ga.y + ba.y); wv.y = cvt_pk_bf16((bflo(v.y) - mu) * rs * ga.z + ba.z, (bfhi(v.y) - mu) * rs * ga.w + ba.w);
                  wv.z = cvt_pk_bf16((bflo(v.z) - mu) * rs * gb.x + bb.x, (bfhi(v.z) - mu) * rs * gb.y + bb.y); wv.w = cvt_pk_bf16((bflo(v.w) - mu) * rs * gb.z + bb.z, (bfhi(v.w) - mu) * rs * gb.w + bb.w);
                  *(u32x4*)(vn + s * RS + dg * 16) = wv; } }
            __syncthreads();
            f32x4 acc[8][2];
#pragma unroll
            for (int tt = 0; tt < 8; ++tt) { acc[tt][0] = (f32x4){0.f, 0.f, 0.f, 0.f}; acc[tt][1] = (f32x4){0.f, 0.f, 0.f, 0.f}; }
            uint2 uw[8][2]; float bias[8];
#pragma unroll
            for (int tt = 0; tt < 8; ++tt) { bias[tt] = bs_[grp * 128 + 16 * tt + i];
#pragma unroll
                for (int nt = 0; nt < 2; ++nt) uw[tt][nt] = *(const uint2*)(ZA + (size_t)(tok0 + 16 * tt + i) * ZAW + ZU + grp * 256 + 32 * wid + 16 * nt + 4 * g4); }
#pragma unroll
            for (int ks = 0; ks < 4; ++ks) { bf16x8 vfr[2];
#pragma unroll
                for (int nt = 0; nt < 2; ++nt) { const unsigned char* bp = vn + (32 * ks + 8 * g4 + (i >> 2)) * RS + (32 * wid + 16 * nt + 4 * (i & 3)) * 2;
                    vfr[nt] = cat44(tr_read(bp), tr_read(bp + 4 * RS)); }
#pragma unroll
                for (int tt = 0; tt < 8; ++tt) if (ks <= tt / 2) { const bf16x8 wf = *(const bf16x8*)(wl + (16 * tt + i) * WRS + (32 * ks + 8 * g4) * 2);
                    acc[tt][0] = MFMA16(vfr[0], wf, acc[tt][0]); acc[tt][1] = MFMA16(vfr[1], wf, acc[tt][1]); } }
#pragma unroll
            for (int tt = 0; tt < 8; ++tt) { const int t = 16 * tt + i;
#pragma unroll
                for (int nt = 0; nt < 2; ++nt) { const int dcol = grp * 256 + 32 * wid + 16 * nt + 4 * g4; const uint2 u2 = uw[tt][nt];
                    uint2 ow; ow.x = cvt_pk_bf16(bflo(u2.x) * (acc[tt][nt][0] + bias[tt]), bfhi(u2.x) * (acc[tt][nt][1] + bias[tt])); ow.y = cvt_pk_bf16(bflo(u2.y) * (acc[tt][nt][2] + bias[tt]), bfhi(u2.y) * (acc[tt][nt][3] + bias[tt]));
                    *(uint2*)(OA + (size_t)(tok0 + t) * 1024 + dcol) = ow; } }
        }
    }
    __syncthreads();
}
__device__ __forceinline__ void build_wsb(const float* __restrict__ ws_, bf16_t* __restrict__ WSB) {
    int tix_ = threadIdx.x; asm volatile("" : "+v"(tix_));
    int bid_ = blockIdx.x, gdim_ = gridDim.x; asm volatile("" : "+s"(bid_), "+s"(gdim_));
    for (int e = bid_ * 512 + tix_; e < 4 * 128 * 128; e += gdim_ * 512) { const int s = e & 127, t = (e >> 7) & 127;
        WSB[e] = (s <= t) ? (bf16_t)(cvt_pk_bf16(ws_[e], 0.f) & 0xffffu) : (bf16_t)0; }
}

#define XB_TMO      128
#define XB_XCNT(j)  (256  + 64 * (j))
#define XB_XSUB(j)  (1280 + 64 * (j))
#define XB_XGEN(j)  (2304 + 64 * (j))
#define XB_TOP      3328
#define XB_TOPGEN   3392
#define XCD_BAR_WORDS 3456
#define XB_SPIN_CAP (1u << 18)
#define LAS __attribute__((address_space(3)))

__device__ __forceinline__ unsigned xb_ld(unsigned* p)              { return __hip_atomic_load(p, __ATOMIC_RELAXED, __HIP_MEMORY_SCOPE_AGENT); }
__device__ __forceinline__ unsigned xb_add(unsigned* p, unsigned v) { return __hip_atomic_fetch_add(p, v, __ATOMIC_RELAXED, __HIP_MEMORY_SCOPE_AGENT); }
__device__ __forceinline__ unsigned xb_xcc_id() { return (unsigned)__builtin_amdgcn_s_getreg((3 << 11) | 20) & 0xFu; }
#define XB_SPIN(cond, bar) do { unsigned _sp = 0; while (cond) { __builtin_amdgcn_s_sleep(1); \
    if ((++_sp & 255u) == 0u) { if (xb_ld(&(bar)[XB_TMO])) break; if (_sp > XB_SPIN_CAP) { atomicAdd(&(bar)[XB_TMO], 1u); break; } } } } while (0)

struct XcdBarrier {
    unsigned* bar; unsigned x;
    volatile LAS unsigned* st;
};

__device__ __forceinline__ XcdBarrier xcd_barrier_post(unsigned* bar, volatile LAS unsigned* st) {
    XcdBarrier b; b.bar = bar; b.x = xb_xcc_id(); b.st = st;
    if (threadIdx.x == 0) (void)xb_add(&bar[XB_XCNT(b.x)], 1u);
    return b;
}
__device__ __forceinline__ void xcd_barrier_complete(unsigned* bar, unsigned x, unsigned& nloc, unsigned& nx) {
    const unsigned G = gridDim.x * gridDim.y * gridDim.z;
    unsigned sum, cnt, mine, sp = 0u;
    for (;;) {
        sum = 0u; cnt = 0u; mine = 0u;
#pragma unroll
        for (unsigned j = 0; j < 16; ++j) { const unsigned c = xb_ld(&bar[XB_XCNT(j)]); sum += c; cnt += (c > 0u) ? 1u : 0u; mine = (j == x) ? c : mine; }
        if (sum == G) break;
        __builtin_amdgcn_s_sleep(1);
        if ((++sp & 255u) == 0u) { if (xb_ld(&bar[XB_TMO])) break; if (sp > XB_SPIN_CAP) { atomicAdd(&bar[XB_TMO], 1u); break; } }
    }
    nloc = mine > 0u ? mine : 1u; nx = cnt > 0u ? cnt : 1u;
}

__device__ __forceinline__ void xcd_barrier(const XcdBarrier& b) {
    asm volatile("s_waitcnt vmcnt(0)" ::: "memory");
    __syncthreads();
    if (threadIdx.x == 0) {
        unsigned* bar = b.bar;
        __builtin_amdgcn_s_waitcnt(0);
        unsigned nloc = b.st[0], nx = b.st[1];
        if (nloc == 0u) { xcd_barrier_complete(bar, b.x, nloc, nx); b.st[0] = nloc; b.st[1] = nx; }
        const unsigned old = xb_add(&bar[XB_XSUB(b.x)], 1u);
        const unsigned gen = old / nloc;
        if (old + 1u == (gen + 1u) * nloc) {
            __builtin_amdgcn_fence(__ATOMIC_RELEASE, "agent");
            asm volatile("s_waitcnt vmcnt(0)" ::: "memory");
            const unsigned og = xb_add(&bar[XB_TOP], 1u);
            const unsigned tg = og / nx;
            if (og + 1u == (tg + 1u) * nx) xb_add(&bar[XB_TOPGEN], 1u);
            else XB_SPIN(xb_ld(&bar[XB_TOPGEN]) == tg, bar);
            __builtin_amdgcn_fence(__ATOMIC_ACQUIRE, "agent");
            xb_add(&bar[XB_XGEN(b.x)], 1u);
            asm volatile("s_waitcnt vmcnt(0)" ::: "memory");
        } else {
            XB_SPIN(xb_ld(&bar[XB_XGEN(b.x)]) == gen, bar);
            __builtin_amdgcn_fence(__ATOMIC_ACQUIRE, "agent");
            asm volatile("s_waitcnt vmcnt(0)" ::: "memory");
        }
    }
    __syncthreads();
}


__device__ __forceinline__ void run_phase(const Params& p, const int ph, unsigned char* shm) {
    using namespace pg8;
    PG8_LAS unsigned char* lds = (PG8_LAS unsigned char*)shm;
    unsigned char* ws = p.ws; bf16_t* H16 = (bf16_t*)(ws + WS_H16);
    bf16_t* XN = (bf16_t*)(ws + WS_XN); bf16_t* ACT = (bf16_t*)(ws + WS_ACT); bf16_t* ZA = ACT; float* Y32 = (float*)(ws + WS_ACT); bf16_t* ZG = (bf16_t*)(ws + WS_ZG);
    bf16_t* OBb = (bf16_t*)(ws + WS_OB); bf16_t* MEMN = (bf16_t*)(ws + WS_MEMN); bf16_t* MKV = (bf16_t*)(ws + WS_MKV); bf16_t* VT = (bf16_t*)(ws + WS_VT); bf16_t* WSB = (bf16_t*)(ws + WS_WSB);
    int G = gridDim.x, c = blockIdx.x; asm volatile("" : "+s"(G), "+s"(c));
    if (ph == N_PHASES - 1) { norm_rows16<true>(H16, p.in[19], p.out, T_TOK); return; }
    const int l = ph / PH_PER_LAYER, q = ph % PH_PER_LAYER;
    switch (q) {
    case 0: {
        int cursor = 0; float* tile = (float*)shm;
        convert_t(p.in[3] + (size_t)l * DM * 2 * DFF, DM, 2 * DFF, (bf16_t*)(ws + WS_W_FFN1_IN), 1, cursor, tile, 1);
        convert_t(p.in[4] + (size_t)l * DFF * DM, DFF, DM, (bf16_t*)(ws + WS_W_FFN1_OUT), 0, cursor, tile, 1);
        convert_t(p.in[6] + (size_t)l * DM * INW, DM, INW, (bf16_t*)(ws + WS_W_WIN), 0, cursor, tile, 1);
        convert_t(p.in[13] + (size_t)l * DM * DM, DM, DM, (bf16_t*)(ws + WS_W_MEMKV), 0, cursor, tile, 1);
        for (int b = 0; b < 3; ++b) convert_t(p.in[14] + ((size_t)l * 3 + b) * 1024 * DM, 1024, DM, (bf16_t*)(ws + WS_W_BR) + (size_t)b * DM * 1024, 0, cursor, tile, 1);
        convert_t(p.in[15] + (size_t)l * DM * DM, DM, DM, (bf16_t*)(ws + WS_W_WOUT), 0, cursor, tile, 1);
        convert_t(p.in[17] + (size_t)l * DM * 2 * DFF, DM, 2 * DFF, (bf16_t*)(ws + WS_W_FFN2_IN), 1, cursor, tile, 1);
        convert_t(p.in[18] + (size_t)l * DFF * DM, DFF, DM, (bf16_t*)(ws + WS_W_FFN2_OUT), 0, cursor, tile, 1);
        if (l == 0) norm_rows<false>(p.in[0], p.in[2] + l * DM, XN, T_TOK); else norm_rows16<false>(H16, p.in[2] + l * DM, XN, T_TOK);
        norm_rows<false>(p.in[1], p.in[12] + l * DM, MEMN, NB * MEML);
        build_wsb(p.in[9] + (size_t)l * 4 * 128 * 128, WSB);
    } break;
    case 1: {
        { Gemm g{XN, (const bf16_t*)(ws + WS_W_FFN1_IN), T_TOK, 2 * DFF, DM}; StaticOrder S; S.init(g.M, g.N, G, c); S.rep = GEMM_REP; EpiSwiGLU E{ACT, DFF}; gemm_phase(lds, g, S, E); }
    } break;
    case 2: { Gemm g{ACT, (const bf16_t*)(ws + WS_W_FFN1_OUT), T_TOK, DM, DFF}; StaticOrder S; S.init(g.M, g.N, G, c); S.wgm = 4;
        if (l == 0) { EpiResid16<true> E{p.in[0], H16, 0.5f}; gemm_phase(lds, g, S, E); } else { EpiResid16<false> E{nullptr, H16, 0.5f}; gemm_phase(lds, g, S, E); } } break;
    case 3: norm_rows16<false>(H16, p.in[5] + l * DM, XN, T_TOK); break;
    case 4: {
        { Gemm g{XN, (const bf16_t*)(ws + WS_W_WIN), T_TOK, INW, DM}; StaticOrder S; S.init(g.M, g.N, G, c); S.rep = WIN_REP; EpiWin E{ZA, ZG}; gemm_phase(lds, g, S, E); }
        { Gemm g{MEMN, (const bf16_t*)(ws + WS_W_MEMKV), NB * MEML, DM, DM}; StaticOrder S; S.init(g.M, g.N, G, (c + 128) % G); EpiMemKV E{MKV, VT}; gemm_phase(lds, g, S, E); }
    } break;
    case 5: {
#if NAIVE_A
        mixA_naive(ZA, p.in[7] + l * 1024, p.in[8] + l * 1024, p.in[9] + (size_t)l * 4 * 128 * 128, p.in[10] + l * 4 * 128, OBb, shm);
#else
        mixA_mfma(ZA, p.in[7] + l * 1024, p.in[8] + l * 1024, WSB, p.in[10] + l * 4 * 128, OBb, shm);
#endif
#if NAIVE_B
        mixB_naive(ZA, p.in[11] + l * 16, OBb + (size_t)T_TOK * 1024);
#else
        mixB_mfma(ZA, p.in[11] + l * 16, OBb + (size_t)T_TOK * 1024, shm);
#endif
#if NAIVE_C
        mixC_naive(ZA, MKV, OBb + (size_t)2 * T_TOK * 1024);
#else
        mixC_lds(ZA, MKV, VT, OBb + (size_t)2 * T_TOK * 1024, shm);
#endif
    } break;
    case 6: { Gemm g{OBb, (const bf16_t*)(ws + WS_W_BR), T_TOK, DM, 1024, (size_t)T_TOK * 1024 * 2, (size_t)DM * 1024 * 2}; ChainOrder S; S.init(g.M, g.N, G, c); S.wgm = 4; EpiBranchChain E{ZG, XN}; gemm_phase(lds, g, S, E); } break;
    case 7: { Gemm g{XN, (const bf16_t*)(ws + WS_W_WOUT), T_TOK, DM, DM}; StaticOrder S; S.init(g.M, g.N, G, c); S.wgm = 4; EpiResid16<false> E{nullptr, H16, 1.0f}; gemm_phase(lds, g, S, E); } break;
    case 8: norm_rows16<false>(H16, p.in[16] + l * DM, XN, T_TOK); break;
    case 9: { Gemm g{XN, (const bf16_t*)(ws + WS_W_FFN2_IN), T_TOK, 2 * DFF, DM}; StaticOrder S; S.init(g.M, g.N, G, c); S.rep = GEMM_REP; EpiSwiGLU E{ACT, DFF}; gemm_phase(lds, g, S, E); } break;
    case 10: { Gemm g{ACT, (const bf16_t*)(ws + WS_W_FFN2_OUT), T_TOK, DM, DFF}; StaticOrder S; S.init(g.M, g.N, G, c); S.wgm = 4; EpiResid16<false> E{nullptr, H16, 0.5f}; gemm_phase(lds, g, S, E); } break;
    }
}

__global__ void __launch_bounds__(512, 2) mega_fwd(Params p, int ph_lo, int ph_hi) {
    extern __shared__ __attribute__((aligned(16))) unsigned char shm[];
    cg::grid_group grid = cg::this_grid();
#if MK_COOP
    const int lo = 0, hi = N_PHASES;
#else
    const int lo = ph_lo, hi = ph_hi;
#endif
#ifdef ONLY_PHASE
#define IN(k) ((k) == ONLY_PHASE)
#else
#define IN(k) (lo <= (k) && (k) < hi)
#endif
    if (threadIdx.x == 0) { ((unsigned*)(shm + 131072))[0] = 0u; ((unsigned*)(shm + 131072))[1] = 0u; ((unsigned*)(shm + 131072))[2] = 0u; ((unsigned*)(shm + 131072))[3] = 0u; }
    __syncthreads();
    XcdBarrier xbar = xcd_barrier_post((unsigned*)(p.ws + WS_BAR), (volatile LAS unsigned*)(shm + 131072));
#define SEAM(k) do { if ((k) == 0) grid.sync(); else xcd_barrier(xbar); } while (0)
#define PHASE(k) if (IN(k)) { auto ka = __builtin_amdgcn_kernarg_segment_ptr(); asm volatile("" : "+s"(ka)); Params pl; __builtin_memcpy(&pl, (const __attribute__((address_space(4))) Params*)ka, sizeof(Params)); run_phase(pl, (k), shm); if (IN((k) + 1)) { SEAM(k); if (SYNC_REP > 1) SEAM(k); } }
    PHASE(0) PHASE(1) PHASE(2) PHASE(3) PHASE(4) PHASE(5) PHASE(6) PHASE(7) PHASE(8) PHASE(9) PHASE(10)
    PHASE(11) PHASE(12) PHASE(13) PHASE(14) PHASE(15) PHASE(16) PHASE(17) PHASE(18) PHASE(19) PHASE(20) PHASE(21)
    PHASE(22)
#undef PHASE
#undef IN
}

constexpr int LDS_BYTES = 128 * 1024 + 16;
extern "C" void kernel_launch(void* const* d_in, const int* in_sizes, int n_in, void* d_out, int out_size, void* d_ws, size_t ws_size, hipStream_t stream) {
    static int grid = 0;
    if (grid == 0) {
        int dev = 0, cus = 0, per_cu = 0;
        (void)hipGetDevice(&dev); (void)hipDeviceGetAttribute(&cus, hipDeviceAttributeMultiprocessorCount, dev);
        (void)hipFuncSetAttribute((const void*)mega_fwd, hipFuncAttributeMaxDynamicSharedMemorySize, LDS_BYTES);
        (void)hipOccupancyMaxActiveBlocksPerMultiprocessor(&per_cu, (const void*)mega_fwd, 512, LDS_BYTES);
        if (per_cu < 1) { fprintf(stderr, "kernel_launch: occupancy query says %d blocks/CU\n", per_cu); per_cu = 1; }
        (void)hipGetLastError();
        grid = cus;
        if (ws_size < WS_END) fprintf(stderr, "kernel_launch: workspace too small: %zu < %zu\n", ws_size, (size_t)WS_END);
    }
    (void)hipMemsetAsync((unsigned char*)d_ws + WS_BAR, 0, 16384, stream);
    Params p{};
    for (int i = 0; i < 20; ++i) p.in[i] = (const float*)d_in[i];
    p.out = (float*)d_out; p.ws = (unsigned char*)d_ws;
#if MK_COOP
    int lo = 0, hi = N_PHASES; void* args[] = {&p, &lo, &hi};
    hipError_t e = hipLaunchCooperativeKernel((const void*)mega_fwd, dim3(grid), dim3(512), args, LDS_BYTES, stream);
    if (e != hipSuccess) fprintf(stderr, "cooperative launch failed: %s (grid %d)\n", hipGetErrorString(e), grid);
#else
    for (int ph = 0; ph < N_PHASES; ++ph) hipLaunchKernelGGL(mega_fwd, dim3(grid), dim3(512), LDS_BYTES, stream, p, ph, ph + 1);
#endif
}
```

```cpp
#include <hip/hip_runtime.h>
#include <hip/hip_cooperative_groups.h>
#include <cstdio>
namespace cg = cooperative_groups;

#ifndef MK_COOP
#define MK_COOP 1
#endif
#ifndef DUP_MASK
#define DUP_MASK 0
#endif
#ifndef GEMM_REP
#define GEMM_REP 1
#endif
#ifndef SYNC_REP
#define SYNC_REP 1
#endif
#ifndef WIN_REP
#define WIN_REP 1
#endif
#ifndef EPI_REP
#define EPI_REP 1
#endif
#ifndef FOUT_REP
#define FOUT_REP 1
#endif
#ifndef NORM_REP
#define NORM_REP 1
#endif
#ifndef CONV_REP
#define CONV_REP 1
#endif
#ifndef MIXA_REP
#define MIXA_REP 1
#endif
#ifndef MIXB_REP
#define MIXB_REP 1
#endif
#ifndef MIXC_REP
#define MIXC_REP 1
#endif
#ifndef NAIVE_A
#define NAIVE_A 0
#endif
#ifndef NAIVE_B
#define NAIVE_B 0
#endif
#ifndef NAIVE_C
#define NAIVE_C 0
#endif

constexpr int T_TOK = 16384, DM = 2048, DFF = 5504, SEQ = 4096, NB = 4, MEML = 256;
constexpr int INW = 10752, ZAW = 4608, ZGW = 6144;
constexpr int ZU = 0, ZV = 1024, ZQ = 2048, ZK = 3072, ZVV = 3328, ZMQ = 3584;
constexpr int PH_PER_LAYER = 11, N_PHASES = 2 * PH_PER_LAYER + 1;

namespace pg8 {
#define PG8_LAS __attribute__((address_space(3)))
typedef unsigned short bf16_t;
typedef short bf16x8 __attribute__((ext_vector_type(8)));
typedef float f32x4 __attribute__((ext_vector_type(4)));
typedef unsigned u32x4 __attribute__((ext_vector_type(4)));
constexpr int BM = 256, BK = 64, HALF = 128, HTB = HALF * BK * 2  , STAGE_BYTES = 8 * HTB, NXCD = 8, WGM = 8;

__host__ __device__ __forceinline__ int lds_byte(int r, int c) { const int st = (r >> 4) * 2 + (c >> 5), rr = r & 15, cc = c & 31, ob = rr * 64 + cc * 2; return st * 1024 + (ob ^ (((ob >> 9) & 1) << 5)); }
__host__ __device__ __forceinline__ void stage_rc(int b, int& R, int& C) { const int st = b / 1024, sb = b % 1024, swz = sb ^ (((sb >> 9) & 1) << 5); R = (st >> 1) * 16 + swz / 64; C = (st & 1) * 32 + (swz % 64) / 2; }
__host__ __device__ __forceinline__ int perm32(int rho) { const int n = rho >> 4, i = rho & 15; return 8 * (i >> 2) + 4 * n + (i & 3); }

struct Unit { int pm, pn, br; };
struct Gemm { const bf16_t* A; const bf16_t* Bt; int M, N, K; size_t strideA = 0, strideB = 0; };

struct StaticOrder {
    int nM, nN, nwg, G, c; int rep = 1; int wgm = WGM;
    __host__ __device__ void init(int M, int N, int G_, int c_) { nM = M / BM; nN = N / BM; nwg = nM * nN; G = G_; c = c_; }
    __host__ __device__ bool next(int i, Unit& u) const {
        const long L = (long)i * G + c; if (L >= (long)nwg * rep) return false;
        int wgid = (int)(L % nwg); { const int q = nwg / NXCD, r = nwg % NXCD, xcd = wgid % NXCD, off = wgid / NXCD; wgid = (xcd < r ? xcd * (q + 1) : r * (q + 1) + (xcd - r) * q) + off; }
        const int nig = wgm * nN, gid = wgid / nig, fm = gid * wgm, gsz = (nM - fm) < wgm ? (nM - fm) : wgm;
        u.pm = fm + ((wgid % nig) % gsz); u.pn = (wgid % nig) / gsz; u.br = 0; return true;
    }
    __device__ __forceinline__ void a_ready(const Unit&) const {}
    __device__ __forceinline__ void done(const Unit&) const {}
};
struct ChainOrder : StaticOrder {
    __host__ __device__ bool next(int i, Unit& u) const { const int j = i / 3; if (!StaticOrder::next(j, u)) return false; u.br = i - 3 * j; return true; }
};

__device__ __forceinline__ unsigned cvt_pk_bf16(float lo, float hi) { unsigned r; asm volatile("v_cvt_pk_bf16_f32 %0, %1, %2" : "=v"(r) : "v"(lo), "v"(hi)); return r; }
typedef float f32x2 __attribute__((ext_vector_type(2)));
__device__ __forceinline__ f32x2 gelu_pk(f32x2 v) {
    const f32x2 av = __builtin_elementwise_abs(v), d = av * 0.2316418882f + 1.0f;
    f32x2 t; t.x = __builtin_amdgcn_rcpf(d.x); t.y = __builtin_amdgcn_rcpf(d.y);
    f32x2 q = t * 0.5307027145f + (-0.7265760135f); q = q * t + 0.7107068705f; q = q * t + (-0.142248368f); q = q * t + 0.127414796f; q = q * t;
    const f32x2 s = (v * v) * (-0.72134752044f);
    f32x2 e; e.x = __builtin_amdgcn_exp2f(s.x); e.y = __builtin_amdgcn_exp2f(s.y);
    const f32x2 m = v * (q * e), r = v - m;
    f32x2 o; o.x = v.x < 0.f ? m.x : r.x; o.y = v.y < 0.f ? m.y : r.y; return o;
}
__device__ __forceinline__ float bf2f(bf16_t v) { return __uint_as_float(((unsigned)v) << 16); }
__device__ __forceinline__ float bflo(unsigned w) { return __uint_as_float(w << 16); }
__device__ __forceinline__ float bfhi(unsigned w) { return __uint_as_float(w & 0xffff0000u); }
__device__ __forceinline__ float fast_sigmoid(float x) { return __builtin_amdgcn_rcpf(1.0f + __expf(-x)); }

struct EpiSwiGLU {
    static constexpr bool PERM = true, AFTER_DRAIN = false, IDEMP = true, CHAIN = false;
    bf16_t* O; int ldc;
    __device__ __forceinline__ void operator()(const f32x4 (&acc)[2][2][4][2], const Unit& u, int wr, int wc, int fr, int fq) const {
        const int row0 = u.pm * BM + wr * 64 + fr; const int col0 = u.pn * HALF + wc * 32 + 8 * fq;
#pragma unroll
        for (int ai = 0; ai < 2; ++ai)
#pragma unroll
            for (int m = 0; m < 4; ++m) { bf16_t* rowp = O + (size_t)(row0 + ai * HALF + m * 16) * ldc + col0;
                f32x4 a0 = acc[ai][0][m][0], a1 = acc[ai][0][m][1], b0 = acc[ai][1][m][0], b1 = acc[ai][1][m][1]; f32x4 v0, v1;
#pragma unroll
                for (int j = 0; j < 4; ++j) { v0[j] = a0[j] * fast_sigmoid(a0[j]) * b0[j]; v1[j] = a1[j] * fast_sigmoid(a1[j]) * b1[j]; }
                u32x4 w; w.x = cvt_pk_bf16(v0[0], v0[1]); w.y = cvt_pk_bf16(v0[2], v0[3]); w.z = cvt_pk_bf16(v1[0], v1[1]); w.w = cvt_pk_bf16(v1[2], v1[3]);
                __builtin_nontemporal_store(w, (u32x4*)rowp); }
    }
};
template <bool FIRST> struct EpiResid16 {
    static constexpr bool PERM = true, AFTER_DRAIN = false, IDEMP = false, CHAIN = false;
    const float* X; bf16_t* H; float scale;
    __device__ __forceinline__ void operator()(const f32x4 (&acc)[2][2][4][2], const Unit& u, int wr, int wc, int fr, int fq) const {
        const int row0 = u.pm * BM + wr * 64 + fr, col0 = u.pn * BM + wc * 32 + 8 * fq;
        if (FIRST) {
#pragma unroll
            for (int ai = 0; ai < 2; ++ai)
#pragma unroll
                for (int m = 0; m < 4; ++m) { const size_t off = (size_t)(row0 + ai * HALF + m * 16) * 2048 + col0;
#pragma unroll
                    for (int bj = 0; bj < 2; ++bj) { const size_t o = off + bj * HALF; const f32x4 r0 = *(const f32x4*)(X + o), r1 = *(const f32x4*)(X + o + 4);
                        const f32x4 v0 = r0 + acc[ai][bj][m][0] * scale, v1 = r1 + acc[ai][bj][m][1] * scale;
                        u32x4 w; w.x = cvt_pk_bf16(v0[0], v0[1]); w.y = cvt_pk_bf16(v0[2], v0[3]); w.z = cvt_pk_bf16(v1[0], v1[1]); w.w = cvt_pk_bf16(v1[2], v1[3]);
                        *(u32x4*)(H + o) = w; } }
        } else {
            u32x4 hv[2][4][2];
#pragma unroll
            for (int ai = 0; ai < 2; ++ai)
#pragma unroll
                for (int m = 0; m < 4; ++m)
#pragma unroll
                    for (int bj = 0; bj < 2; ++bj) hv[ai][m][bj] = *(const u32x4*)(H + (size_t)(row0 + ai * HALF + m * 16) * 2048 + col0 + bj * HALF);
#pragma unroll
            for (int ai = 0; ai < 2; ++ai)
#pragma unroll
                for (int m = 0; m < 4; ++m)
#pragma unroll
                    for (int bj = 0; bj < 2; ++bj) { const size_t o = (size_t)(row0 + ai * HALF + m * 16) * 2048 + col0 + bj * HALF; const u32x4 h4 = hv[ai][m][bj];
                        const f32x4 r0 = (f32x4){bflo(h4.x), bfhi(h4.x), bflo(h4.y), bfhi(h4.y)}, r1 = (f32x4){bflo(h4.z), bfhi(h4.z), bflo(h4.w), bfhi(h4.w)};
                        const f32x4 v0 = r0 + acc[ai][bj][m][0] * scale, v1 = r1 + acc[ai][bj][m][1] * scale;
                        u32x4 w; w.x = cvt_pk_bf16(v0[0], v0[1]); w.y = cvt_pk_bf16(v0[2], v0[3]); w.z = cvt_pk_bf16(v1[0], v1[1]); w.w = cvt_pk_bf16(v1[2], v1[3]);
                        *(u32x4*)(H + o) = w; }
        }
    }
};
struct EpiPlainBf16 {
    static constexpr bool PERM = true, AFTER_DRAIN = false, IDEMP = false, CHAIN = false;
    bf16_t* O; int ldc;
    __device__ __forceinline__ void operator()(const f32x4 (&acc)[2][2][4][2], const Unit& u, int wr, int wc, int fr, int fq) const {
        const int row0 = u.pm * BM + wr * 64 + fr, col0 = u.pn * BM + wc * 32 + 8 * fq;
#pragma unroll
        for (int ai = 0; ai < 2; ++ai)
#pragma unroll
            for (int m = 0; m < 4; ++m) { bf16_t* rowp = O + (size_t)(row0 + ai * HALF + m * 16) * ldc + col0;
#pragma unroll
                for (int bj = 0; bj < 2; ++bj) { const f32x4 v0 = acc[ai][bj][m][0], v1 = acc[ai][bj][m][1];
                    u32x4 w; w.x = cvt_pk_bf16(v0[0], v0[1]); w.y = cvt_pk_bf16(v0[2], v0[3]); w.z = cvt_pk_bf16(v1[0], v1[1]); w.w = cvt_pk_bf16(v1[2], v1[3]);
                    *(u32x4*)(rowp + bj * HALF) = w; } }
    }
};
struct EpiWin {
    static constexpr bool PERM = true, AFTER_DRAIN = false, IDEMP = true, CHAIN = false;
    bf16_t* ZA; bf16_t* ZG;
    __device__ __forceinline__ void operator()(const f32x4 (&acc)[2][2][4][2], const Unit& u, int wr, int wc, int fr, int fq) const {
        const int row0 = u.pm * BM + wr * 64 + fr; const int pn = u.pn;
        const int mode = pn < 8 ? 1 : (pn < 18 ? 0 : 2);
        bf16_t* base = mode == 2 ? ZG : ZA; const int ldc = mode == 2 ? ZGW : ZAW; const int col0 = (mode == 2 ? (pn - 18) : pn) * BM + wc * 32 + 8 * fq;
#pragma unroll
        for (int ai = 0; ai < 2; ++ai)
#pragma unroll
            for (int m = 0; m < 4; ++m) { bf16_t* rowp = base + (size_t)(row0 + ai * HALF + m * 16) * ldc + col0;
#pragma unroll
                for (int bj = 0; bj < 2; ++bj) { f32x4 v0 = acc[ai][bj][m][0], v1 = acc[ai][bj][m][1];
                    if (mode == 1) { f32x2 a = gelu_pk((f32x2){v0[0], v0[1]}), b = gelu_pk((f32x2){v0[2], v0[3]}), c = gelu_pk((f32x2){v1[0], v1[1]}), d = gelu_pk((f32x2){v1[2], v1[3]});
                        v0 = (f32x4){a.x, a.y, b.x, b.y}; v1 = (f32x4){c.x, c.y, d.x, d.y}; }
                    else if (mode == 2) {
#pragma unroll
                        for (int j = 0; j < 4; ++j) { v0[j] = fast_sigmoid(v0[j]); v1[j] = fast_sigmoid(v1[j]); } }
                    u32x4 w; w.x = cvt_pk_bf16(v0[0], v0[1]); w.y = cvt_pk_bf16(v0[2], v0[3]); w.z = cvt_pk_bf16(v1[0], v1[1]); w.w = cvt_pk_bf16(v1[2], v1[3]);
                    *(u32x4*)(rowp + bj * HALF) = w; } }
    }
};
struct EpiMemKV {
    static constexpr bool PERM = true, AFTER_DRAIN = false, IDEMP = false, CHAIN = false;
    bf16_t* O; bf16_t* VT;
    __device__ __forceinline__ void operator()(const f32x4 (&acc)[2][2][4][2], const Unit& u, int wr, int wc, int fr, int fq) const {
        const int row0 = u.pm * BM + wr * 64 + fr, col0 = u.pn * BM + wc * 32 + 8 * fq;
#pragma unroll
        for (int ai = 0; ai < 2; ++ai)
#pragma unroll
            for (int m = 0; m < 4; ++m) { const int row = row0 + ai * HALF + m * 16;
#pragma unroll
                for (int bj = 0; bj < 2; ++bj) { const f32x4 v0 = acc[ai][bj][m][0], v1 = acc[ai][bj][m][1]; const int col = col0 + bj * HALF;
                    u32x4 w; w.x = cvt_pk_bf16(v0[0], v0[1]); w.y = cvt_pk_bf16(v0[2], v0[3]); w.z = cvt_pk_bf16(v1[0], v1[1]); w.w = cvt_pk_bf16(v1[2], v1[3]);
                    if (u.pn < 4) *(u32x4*)(O + (size_t)row * 2048 + col) = w;
                    else { const int cc = col - 1024, hh = cc >> 8, d = cc & 255, b = row >> 8, mm = row & 255; bf16_t* vt = VT + ((size_t)((b * 4 + hh) * 256 + d)) * 256 + mm;
                        vt[0] = (bf16_t)(w.x & 0xffffu); vt[256] = (bf16_t)(w.x >> 16); vt[512] = (bf16_t)(w.y & 0xffffu); vt[768] = (bf16_t)(w.y >> 16);
                        vt[1024] = (bf16_t)(w.z & 0xffffu); vt[1280] = (bf16_t)(w.z >> 16); vt[1536] = (bf16_t)(w.w & 0xffffu); vt[1792] = (bf16_t)(w.w >> 16); } } }
    }
};
struct EpiBranchChain {
    static constexpr bool PERM = true, AFTER_DRAIN = false, IDEMP = false, CHAIN = true;
    const bf16_t* G; bf16_t* YB;
    __device__ __forceinline__ void operator()(f32x4 (&acc)[2][2][4][2], const Unit& u, int wr, int wc, int fr, int fq) const {
        const int row0 = u.pm * BM + wr * 64 + fr, col0 = u.pn * BM + wc * 32 + 8 * fq; const int br = u.br;
#pragma unroll
        for (int ai = 0; ai < 2; ++ai) {
            u32x4 ga[4][2], gb[4][2];
#pragma unroll
            for (int m = 0; m < 4; ++m)
#pragma unroll
                for (int bj = 0; bj < 2; ++bj) { const bf16_t* gp = G + (size_t)(row0 + ai * HALF + m * 16) * ZGW + br * 2048 + col0 + bj * HALF;
                    ga[m][bj] = *(const u32x4*)gp; if (br < 2) gb[m][bj] = *(const u32x4*)(gp + 2048); }
#pragma unroll
            for (int m = 0; m < 4; ++m) { const size_t row = (size_t)(row0 + ai * HALF + m * 16);
#pragma unroll
                for (int bj = 0; bj < 2; ++bj) { const int col = col0 + bj * HALF; const u32x4 a4 = ga[m][bj];
                    f32x4 g0 = (f32x4){bflo(a4.x), bfhi(a4.x), bflo(a4.y), bfhi(a4.y)}, g1 = (f32x4){bflo(a4.z), bfhi(a4.z), bflo(a4.w), bfhi(a4.w)};
                    if (br < 2) { const u32x4 b4 = gb[m][bj];
                        g0[0] *= __builtin_amdgcn_rcpf(bflo(b4.x)); g0[1] *= __builtin_amdgcn_rcpf(bfhi(b4.x)); g0[2] *= __builtin_amdgcn_rcpf(bflo(b4.y)); g0[3] *= __builtin_amdgcn_rcpf(bfhi(b4.y));
                        g1[0] *= __builtin_amdgcn_rcpf(bflo(b4.z)); g1[1] *= __builtin_amdgcn_rcpf(bfhi(b4.z)); g1[2] *= __builtin_amdgcn_rcpf(bflo(b4.w)); g1[3] *= __builtin_amdgcn_rcpf(bfhi(b4.w));
                        acc[ai][bj][m][0] *= g0; acc[ai][bj][m][1] *= g1; }
                    else { const f32x4 v0 = acc[ai][bj][m][0] * g0, v1 = acc[ai][bj][m][1] * g1;
                        u32x4 w; w.x = cvt_pk_bf16(v0[0], v0[1]); w.y = cvt_pk_bf16(v0[2], v0[3]); w.z = cvt_pk_bf16(v1[0], v1[1]); w.w = cvt_pk_bf16(v1[2], v1[3]);
                        *(u32x4*)(YB + row * 2048 + col) = w; } } }
        }
    }
};
template <int MODE> struct EpiBranch {
    static constexpr bool PERM = false, AFTER_DRAIN = false, IDEMP = false, CHAIN = false;
    const bf16_t* G; int gcol0; float* Y32; bf16_t* YB;
    __device__ __forceinline__ void operator()(const f32x4 (&acc)[2][2][4][2], const Unit& u, int wr, int wc, int fr, int fq) const {
        const int row0 = u.pm * BM + wr * 64 + fr, col0 = u.pn * BM + wc * 32 + 4 * fq;
#pragma unroll
        for (int ai = 0; ai < 2; ++ai)
#pragma unroll
            for (int m = 0; m < 4; ++m) { const size_t row = (size_t)(row0 + ai * HALF + m * 16);
#pragma unroll
                for (int bj = 0; bj < 2; ++bj)
#pragma unroll
                    for (int n = 0; n < 2; ++n) { const int col = col0 + bj * HALF + n * 16;
                        const uint2 gw = *(const uint2*)(G + row * ZGW + gcol0 + col);
                        f32x4 gv = (f32x4){bflo(gw.x), bfhi(gw.x), bflo(gw.y), bfhi(gw.y)};
                        f32x4 v = gv * acc[ai][bj][m][n];
                        if (MODE >= 1) v += *(const f32x4*)(Y32 + row * DM + col);
                        if (MODE <= 1) *(f32x4*)(Y32 + row * DM + col) = v;
                        else { uint2 w; w.x = cvt_pk_bf16(v[0], v[1]); w.y = cvt_pk_bf16(v[2], v[3]); *(uint2*)(YB + row * DM + col) = w; } } }
    }
};
template <class Epi, class Sched>
__device__ __forceinline__ void gemm_phase(PG8_LAS unsigned char* lds, const Gemm g, const Sched& S, const Epi& E) {
    int tix_ = threadIdx.x; asm volatile("" : "+v"(tix_));
    const int tid = tix_, wid = __builtin_amdgcn_readfirstlane(tid >> 6), lane = tid & 63, wr = wid >> 2, wc = wid & 3, fr = lane & 15, fq = lane >> 4;
    const int K = g.K, nt = K / BK;
    unsigned voffA[2], voffB[2];
#pragma unroll
    for (int i = 0; i < 2; ++i) { int R, C; stage_rc(tid * 16 + i * 8192, R, C);
        voffA[i] = (unsigned)(R * K + C) * 2u; voffB[i] = (unsigned)(tid * 16 + i * 8192); }
    const size_t kstep = (size_t)(BK * 2);
    const size_t hstep = (size_t)HALF * K * 2;
    const size_t tstep = 2 * hstep;
    const size_t kstepB = 32768, hstepB = 16384, tstepB = (size_t)nt * 32768;
    const unsigned ldsw = (unsigned)wid * 1024u;
    const int aoff = lds_byte(wr * 64 + fr, fq * 8), boff = lds_byte(wc * 32 + fr, fq * 8);
#define PG8_SA(b, h) (((b) * 2 + (h)) * HTB)
#define PG8_SB(b, h) ((4 + (b) * 2 + (h)) * HTB)
#define PG8_STAGE(bufoff, gbase, voff) do { _Pragma("unroll") for (int _i = 0; _i < 2; ++_i) \
        __builtin_amdgcn_global_load_lds((const unsigned*)((const char*)(gbase) + (voff)[_i]), (PG8_LAS unsigned*)(lds + (bufoff) + ldsw + _i * 8192), 16, 0, 0); } while (0)
#define PG8_LDA(dst, b, h) do { _Pragma("unroll") for (int m = 0; m < 4; ++m) _Pragma("unroll") for (int k = 0; k < 2; ++k) dst[m][k] = *(const PG8_LAS bf16x8*)(lds + PG8_SA(b, h) + aoff + m * 2048 + k * 1024); } while (0)
#define PG8_LDB(dst, b, h) do { _Pragma("unroll") for (int n = 0; n < 2; ++n) _Pragma("unroll") for (int k = 0; k < 2; ++k) dst[n][k] = *(const PG8_LAS bf16x8*)(lds + PG8_SB(b, h) + boff + n * 2048 + k * 1024); } while (0)
#define PG8_MMA(ai, bj, At, Bt) do { __builtin_amdgcn_s_setprio(1); _Pragma("unroll") for (int m = 0; m < 4; ++m) _Pragma("unroll") for (int n = 0; n < 2; ++n) _Pragma("unroll") for (int k = 0; k < 2; ++k) \
        acc[ai][bj][m][n] = __builtin_amdgcn_mfma_f32_16x16x32_bf16(Bt[n][k], At[m][k], acc[ai][bj][m][n], 0, 0, 0); __builtin_amdgcn_s_setprio(0); } while (0)
#define PG8_WAIT_V(n) asm volatile("s_waitcnt vmcnt(" #n ")" ::: "memory")
#define PG8_WAIT_L(n) asm volatile("s_waitcnt lgkmcnt(" #n ")" ::: "memory")
#define PG8_BAR __builtin_amdgcn_s_barrier()
#define PG8_SCHED __builtin_amdgcn_sched_barrier(0)
    Unit cur, nxt; int ui = 0;
    if (!S.next(0, cur)) return;
    f32x4 acc[2][2][4][2];
#pragma unroll
    for (int a = 0; a < 2; ++a)
#pragma unroll
        for (int b = 0; b < 2; ++b)
#pragma unroll
            for (int m = 0; m < 4; ++m)
#pragma unroll
                for (int n = 0; n < 2; ++n) acc[a][b][m][n] = (f32x4){0.f, 0.f, 0.f, 0.f};
    bf16x8 At[4][2], B0[2][2], B1[2][2];
    const char* cA = (const char*)g.A + (size_t)cur.pm * tstep + (size_t)cur.br * g.strideA; const char* cB = (const char*)g.Bt + (size_t)cur.pn * tstepB + (size_t)cur.br * g.strideB;
    S.a_ready(cur);
    PG8_STAGE(PG8_SB(0, 0), cB, voffB); PG8_STAGE(PG8_SA(0, 0), cA, voffA); PG8_STAGE(PG8_SB(0, 1), cB + hstepB, voffB); PG8_STAGE(PG8_SA(0, 1), cA + hstep, voffA);
    if (wr == 1) PG8_BAR;
    PG8_WAIT_V(4); PG8_BAR;
    PG8_STAGE(PG8_SB(1, 0), cB + kstepB, voffB); PG8_STAGE(PG8_SA(1, 0), cA + kstep, voffA); PG8_STAGE(PG8_SB(1, 1), cB + hstepB + kstepB, voffB);
    PG8_WAIT_V(6); PG8_BAR;
    for (;;) {
        const bool has_next = S.next(ui + 1, nxt);
        const char* nA = has_next ? (const char*)g.A + (size_t)nxt.pm * tstep + (size_t)nxt.br * g.strideA : cA; const char* nB = has_next ? (const char*)g.Bt + (size_t)nxt.pn * tstepB + (size_t)nxt.br * g.strideB : cB;
        for (int t = 0; t < nt; t += 2) {
            const bool last = (t == nt - 2);
            const char* a1 = cA + (size_t)(t + 1) * kstep;
            const char* a2 = last ? nA : cA + (size_t)(t + 2) * kstep; const char* b2 = last ? nB : cB + (size_t)(t + 2) * kstepB;
            const char* a3 = a2 + kstep; const char* b3 = b2 + kstepB;
            if (last && has_next) S.a_ready(nxt);
            PG8_LDB(B0, 0, 0); PG8_SCHED; PG8_LDA(At, 0, 0); PG8_STAGE(PG8_SA(1, 1), a1 + hstep, voffA);
            PG8_WAIT_L(8); PG8_BAR; PG8_WAIT_L(0); PG8_MMA(0, 0, At, B0); PG8_BAR; PG8_SCHED;
            PG8_LDB(B1, 0, 1); PG8_STAGE(PG8_SB(0, 0), b2, voffB);
            PG8_BAR; PG8_WAIT_L(0); PG8_MMA(0, 1, At, B1); PG8_BAR;
            PG8_LDA(At, 0, 1); PG8_STAGE(PG8_SA(0, 0), a2, voffA);
            PG8_BAR; PG8_WAIT_L(0); PG8_MMA(1, 0, At, B0); PG8_BAR; PG8_SCHED;
            PG8_STAGE(PG8_SB(0, 1), b2 + hstepB, voffB);
            PG8_WAIT_V(6); PG8_BAR; PG8_MMA(1, 1, At, B1); PG8_BAR;
            PG8_LDB(B0, 1, 0); PG8_SCHED; PG8_LDA(At, 1, 0); PG8_STAGE(PG8_SA(0, 1), a2 + hstep, voffA);
            PG8_WAIT_L(8); PG8_BAR; PG8_WAIT_L(0); PG8_MMA(0, 0, At, B0); PG8_BAR; PG8_SCHED;
            PG8_LDB(B1, 1, 1); PG8_STAGE(PG8_SB(1, 0), b3, voffB);
            PG8_BAR; PG8_WAIT_L(0); PG8_MMA(0, 1, At, B1); PG8_BAR;
            PG8_LDA(At, 1, 1); PG8_STAGE(PG8_SA(1, 0), a3, voffA);
            PG8_BAR; PG8_WAIT_L(0); PG8_MMA(1, 0, At, B0); PG8_BAR; PG8_SCHED;
            PG8_STAGE(PG8_SB(1, 1), b3 + hstepB, voffB);
            PG8_WAIT_V(6); PG8_BAR; PG8_MMA(1, 1, At, B1); PG8_BAR;
        }
        if constexpr (!Epi::AFTER_DRAIN) { E(acc, cur, wr, wc, fr, fq); if constexpr (Epi::IDEMP && EPI_REP > 1) { asm volatile("" ::: "memory"); E(acc, cur, wr, wc, fr, fq); } S.done(cur); }
        if (!has_next) break;
        if (!(Epi::CHAIN && cur.br < 2))
#pragma unroll
        for (int a = 0; a < 2; ++a)
#pragma unroll
            for (int b = 0; b < 2; ++b)
#pragma unroll
                for (int m = 0; m < 4; ++m)
#pragma unroll
                    for (int n = 0; n < 2; ++n) acc[a][b][m][n] = (f32x4){0.f, 0.f, 0.f, 0.f};
        cur = nxt; cA = nA; cB = nB; ++ui;
    }
    PG8_WAIT_V(0);
    if (wr == 0) PG8_BAR;
    PG8_BAR;
    if constexpr (Epi::AFTER_DRAIN) { E.fused(acc, cur, wr, wc, fr, fq, lds, wid, lane); S.done(cur); }
#undef PG8_SA
#undef PG8_SB
#undef PG8_STAGE
#undef PG8_LDA
#undef PG8_LDB
#undef PG8_MMA
#undef PG8_WAIT_V
#undef PG8_WAIT_L
#undef PG8_BAR
#undef PG8_SCHED
}
}
using pg8::bf16_t; using pg8::f32x4; using pg8::u32x4; using pg8::bf2f; using pg8::bflo; using pg8::bfhi; using pg8::cvt_pk_bf16;

constexpr size_t SZ_FFN_IN = (size_t)2 * DFF * DM * 2, SZ_FFN_OUT = (size_t)DM * DFF * 2, SZ_WIN = (size_t)INW * DM * 2, SZ_SQ = (size_t)DM * DM * 2, SZ_BR = (size_t)3 * DM * 1024 * 2;
constexpr size_t WS_W_FFN1_IN = 0, WS_W_FFN1_OUT = WS_W_FFN1_IN + SZ_FFN_IN, WS_W_WIN = WS_W_FFN1_OUT + SZ_FFN_OUT, WS_W_MEMKV = WS_W_WIN + SZ_WIN, WS_W_BR = WS_W_MEMKV + SZ_SQ,
                 WS_W_WOUT = WS_W_BR + SZ_BR, WS_W_FFN2_IN = WS_W_WOUT + SZ_SQ, WS_W_FFN2_OUT = WS_W_FFN2_IN + SZ_FFN_IN, WS_XN = WS_W_FFN2_OUT + SZ_FFN_OUT,
                 WS_ACT = WS_XN + (size_t)T_TOK * DM * 2, WS_ZG = WS_ACT + (size_t)T_TOK * DFF * 2, WS_OB = WS_ZG + (size_t)T_TOK * ZGW * 2,
                 WS_MEMN = WS_OB + (size_t)3 * T_TOK * 1024 * 2, WS_MKV = WS_MEMN + (size_t)1024 * DM * 2, WS_VT = WS_MKV + (size_t)1024 * DM * 2, WS_WSB = WS_VT + (size_t)16 * 256 * 256 * 2, WS_BAR = WS_WSB + (size_t)4 * 128 * 128 * 2, WS_H16 = WS_BAR + 16384, WS_END = WS_H16 + (size_t)T_TOK * DM * 2;

struct Params { const float* in[20]; float* out; unsigned char* ws; };

__device__ __forceinline__ float wave_sum(float v) {
#pragma unroll
    for (int o = 32; o >= 1; o >>= 1) v += __shfl_xor(v, o);
    return v;
}
__device__ __forceinline__ float wave_max(float v) {
#pragma unroll
    for (int o = 32; o >= 1; o >>= 1) v = fmaxf(v, __shfl_xor(v, o));
    return v;
}

__device__ __forceinline__ void convert_t(const float* __restrict__ W, int K, int N, bf16_t* __restrict__ Wt, int swiglu, int& cursor, float* tile, int perm) {
    int bid_ = blockIdx.x, gdim_ = gridDim.x; asm volatile("" : "+s"(bid_), "+s"(gdim_));
    int tix_ = threadIdx.x; asm volatile("" : "+v"(tix_));
    const int tid = tix_, G = gdim_; const int ntn = N / 256, nt = (K / 64) * ntn;
    const int first = cursor; cursor += nt;
    int id = first + (((int)bid_ - (first % G)) + G) % G;
    const int last = first + nt * CONV_REP;
    float4 v[8];
    if (id < last) { const int tl = (id - first) % nt; const int k0 = (tl / ntn) * 64, n0 = (tl % ntn) * 256;
#pragma unroll
        for (int i = 0; i < 8; ++i) { const int idx = tid + 512 * i; const int row = idx >> 6, c4 = idx & 63; v[i] = *(const float4*)(W + (size_t)(k0 + row) * N + n0 + 4 * c4); } }
    for (; id < last; id += G) {
        const int tl = (id - first) % nt; const int k0 = (tl / ntn) * 64, n0 = (tl % ntn) * 256;
#pragma unroll
        for (int i = 0; i < 8; ++i) { const int idx = tid + 512 * i; const int row = idx >> 6, c4 = idx & 63; float* d = tile + row * 257 + 4 * c4; d[0] = v[i].x; d[1] = v[i].y; d[2] = v[i].z; d[3] = v[i].w; }
        __syncthreads();
        if (id + G < last) { const int tl2 = (id + G - first) % nt; const int k2 = (tl2 / ntn) * 64, n2 = (tl2 % ntn) * 256;
#pragma unroll
            for (int i = 0; i < 8; ++i) { const int idx = tid + 512 * i; const int row = idx >> 6, c4 = idx & 63; v[i] = *(const float4*)(W + (size_t)(k2 + row) * N + n2 + 4 * c4); } }
#pragma unroll
        for (int p = 0; p < 4; ++p) { const int nl = (tid >> 3) + 64 * p, kq = tid & 7; const float* s = tile + (8 * kq) * 257 + nl;
            u32x4 w; w.x = cvt_pk_bf16(s[0], s[257]); w.y = cvt_pk_bf16(s[2 * 257], s[3 * 257]); w.z = cvt_pk_bf16(s[4 * 257], s[5 * 257]); w.w = cvt_pk_bf16(s[6 * 257], s[7 * 257]);
            int n = n0 + nl; if (swiglu) { const int half = n >= DFF ? 1 : 0; const int c = n - half * DFF; n = (c >> 7) * 256 + half * 128 + (c & 127); }
            { const int pn = n >> 8, half = (n >> 7) & 1, r = n & 127, c5 = r & 31;
              const int R = perm ? ((r & ~31) + 16 * ((c5 >> 2) & 1) + 4 * (c5 >> 3) + (c5 & 3)) : r;
              *(u32x4*)((unsigned char*)Wt + ((size_t)pn * (K >> 6) + (k0 >> 6)) * 32768 + half * 16384 + pg8::lds_byte(R, 8 * kq)) = w; } }
        __syncthreads();
    }
}

template <bool F32OUT> __device__ __forceinline__ void norm_rows(const float* X, const float* __restrict__ g, void* out, int rows) {
    int bid_ = blockIdx.x, gdim_ = gridDim.x; asm volatile("" : "+s"(bid_), "+s"(gdim_));
    int tix_ = threadIdx.x; asm volatile("" : "+v"(tix_));
    constexpr int NREP = F32OUT ? 1 : NORM_REP;
    const int lane = tix_ & 63, gw = __builtin_amdgcn_readfirstlane(bid_ * 8 + (tix_ >> 6)), GW = gdim_ * 8;
    float4 gv[8];
#pragma unroll
    for (int i = 0; i < 8; ++i) gv[i] = *(const float4*)(g + 4 * lane + 256 * i);
    int row = gw; float4 x[8];
    if (row < rows * NREP) {
#pragma unroll
        for (int i = 0; i < 8; ++i) x[i] = *(const float4*)(X + (size_t)(NREP > 1 ? row % rows : row) * DM + 4 * lane + 256 * i); }
    while (row < rows * NREP) {
        const int nrow = row + GW; float4 xn[8];
        if (nrow < rows * NREP) {
#pragma unroll
            for (int i = 0; i < 8; ++i) xn[i] = *(const float4*)(X + (size_t)(NREP > 1 ? nrow % rows : nrow) * DM + 4 * lane + 256 * i); }
        float ss = 0.f;
#pragma unroll
        for (int i = 0; i < 8; ++i) ss += x[i].x * x[i].x + x[i].y * x[i].y + x[i].z * x[i].z + x[i].w * x[i].w;
        ss = wave_sum(ss);
        const float rstd = rsqrtf(ss * (1.0f / DM) + 1e-6f);
#pragma unroll
        for (int i = 0; i < 8; ++i) {
            const float a = x[i].x * rstd * gv[i].x, b = x[i].y * rstd * gv[i].y, c = x[i].z * rstd * gv[i].z, d = x[i].w * rstd * gv[i].w;
            if (F32OUT) *(float4*)((float*)out + (size_t)(NREP > 1 ? row % rows : row) * DM + 4 * lane + 256 * i) = make_float4(a, b, c, d);
            else { uint2 w; w.x = cvt_pk_bf16(a, b); w.y = cvt_pk_bf16(c, d); *(uint2*)((bf16_t*)out + (size_t)(NREP > 1 ? row % rows : row) * DM + 4 * lane + 256 * i) = w; }
        }
#pragma unroll
        for (int i = 0; i < 8; ++i) x[i] = xn[i];
        row = nrow;
    }
}

template <bool F32OUT> __device__ __forceinline__ void norm_rows16(const bf16_t* X, const float* __restrict__ g, void* out, int rows) {
    int bid_ = blockIdx.x, gdim_ = gridDim.x; asm volatile("" : "+s"(bid_), "+s"(gdim_));
    int tix_ = threadIdx.x; asm volatile("" : "+v"(tix_));
    const int lane = tix_ & 63, gw = __builtin_amdgcn_readfirstlane(bid_ * 8 + (tix_ >> 6)), GW = gdim_ * 8;
    float4 ga[4], gb[4];
#pragma unroll
    for (int i = 0; i < 4; ++i) { ga[i] = *(const float4*)(g + 8 * lane + 512 * i); gb[i] = *(const float4*)(g + 8 * lane + 512 * i + 4); }
    int row = gw; u32x4 x[4];
    if (row < rows) {
#pragma unroll
        for (int i = 0; i < 4; ++i) x[i] = *(const u32x4*)(X + (size_t)row * DM + 8 * lane + 512 * i); }
    while (row < rows) {
        const int nrow = row + GW; u32x4 xn[4];
        if (nrow < rows) {
#pragma unroll
            for (int i = 0; i < 4; ++i) xn[i] = *(const u32x4*)(X + (size_t)nrow * DM + 8 * lane + 512 * i); }
        float v[4][8]; float ss = 0.f;
#pragma unroll
        for (int i = 0; i < 4; ++i) { v[i][0] = bflo(x[i].x); v[i][1] = bfhi(x[i].x); v[i][2] = bflo(x[i].y); v[i][3] = bfhi(x[i].y); v[i][4] = bflo(x[i].z); v[i][5] = bfhi(x[i].z); v[i][6] = bflo(x[i].w); v[i][7] = bfhi(x[i].w);
#pragma unroll
            for (int e = 0; e < 8; ++e) ss += v[i][e] * v[i][e]; }
        ss = wave_sum(ss);
        const float rstd = rsqrtf(ss * (1.0f / DM) + 1e-6f);
#pragma unroll
        for (int i = 0; i < 4; ++i) {
            const float o0 = v[i][0] * rstd * ga[i].x, o1 = v[i][1] * rstd * ga[i].y, o2 = v[i][2] * rstd * ga[i].z, o3 = v[i][3] * rstd * ga[i].w;
            const float o4 = v[i][4] * rstd * gb[i].x, o5 = v[i][5] * rstd * gb[i].y, o6 = v[i][6] * rstd * gb[i].z, o7 = v[i][7] * rstd * gb[i].w;
            if (F32OUT) { float* op = (float*)out + (size_t)row * DM + 8 * lane + 512 * i; *(float4*)op = make_float4(o0, o1, o2, o3); *(float4*)(op + 4) = make_float4(o4, o5, o6, o7); }
            else { u32x4 w; w.x = cvt_pk_bf16(o0, o1); w.y = cvt_pk_bf16(o2, o3); w.z = cvt_pk_bf16(o4, o5); w.w = cvt_pk_bf16(o6, o7); *(u32x4*)((bf16_t*)out + (size_t)row * DM + 8 * lane + 512 * i) = w; }
        }
#pragma unroll
        for (int i = 0; i < 4; ++i) x[i] = xn[i];
        row = nrow;
    }
}

__device__ __forceinline__ void mixC_naive(const bf16_t* __restrict__ ZA, const bf16_t* __restrict__ MKV, bf16_t* __restrict__ OC) {
    const int lane = threadIdx.x & 63, gw = __builtin_amdgcn_readfirstlane(blockIdx.x * 8 + (threadIdx.x >> 6)), GW = gridDim.x * 8;
    for (int task = gw; task < T_TOK * 4; task += GW) {
        const int tok = task >> 2, h = task & 3, b = tok >> 12;
        const uint2 qv = *(const uint2*)(ZA + (size_t)tok * ZAW + ZMQ + h * 256 + lane * 4);
        const float q0 = bflo(qv.x), q1 = bfhi(qv.x), q2 = bflo(qv.y), q3 = bfhi(qv.y);
        const bf16_t* kb = MKV + (size_t)(b * 256) * DM + h * 256 + lane * 4;
        float sc[4];
#pragma unroll
        for (int i = 0; i < 4; ++i) { sc[i] = 0.f;
            for (int mm = 0; mm < 64; ++mm) { const uint2 kv = *(const uint2*)(kb + (size_t)(i * 64 + mm) * DM);
                float s = q0 * bflo(kv.x) + q1 * bfhi(kv.x) + q2 * bflo(kv.y) + q3 * bfhi(kv.y); s = wave_sum(s); sc[i] = (lane == mm) ? s : sc[i]; } }
        float mx = fmaxf(fmaxf(sc[0], sc[1]), fmaxf(sc[2], sc[3])); mx = wave_max(mx);
        float ps = 0.f;
#pragma unroll
        for (int i = 0; i < 4; ++i) { sc[i] = __expf((sc[i] - mx) * 0.0625f); ps += sc[i]; }
        ps = wave_sum(ps); const float inv = 1.0f / ps;
        float o0 = 0.f, o1 = 0.f, o2 = 0.f, o3 = 0.f;
#pragma unroll
        for (int i = 0; i < 4; ++i)
            for (int mm = 0; mm < 64; ++mm) { const float pm = __shfl(sc[i], mm); const uint2 vv = *(const uint2*)(kb + (size_t)(i * 64 + mm) * DM + 1024);
                o0 += pm * bflo(vv.x); o1 += pm * bfhi(vv.x); o2 += pm * bflo(vv.y); o3 += pm * bfhi(vv.y); }
        uint2 w; w.x = cvt_pk_bf16(o0 * inv, o1 * inv); w.y = cvt_pk_bf16(o2 * inv, o3 * inv);
        *(uint2*)(OC + (size_t)tok * 1024 + h * 256 + lane * 4) = w;
    }
}
__device__ __forceinline__ void mixB_naive(const bf16_t* __restrict__ ZA, const float* __restrict__ sinks, bf16_t* __restrict__ OBo) {
    const int lane = threadIdx.x & 63, gw = __builtin_amdgcn_readfirstlane(blockIdx.x * 8 + (threadIdx.x >> 6)), GW = gridDim.x * 8;
    const int r = lane >> 4, i4 = lane & 15;
    for (int task = gw; task < T_TOK * 4; task += GW) {
        const int tok = task >> 2, hk = task & 3, pos = tok & (SEQ - 1), h = hk * 4 + r;
        const uint2 qv = *(const uint2*)(ZA + (size_t)tok * ZAW + ZQ + h * 64 + i4 * 4);
        const float q0 = bflo(qv.x), q1 = bfhi(qv.x), q2 = bflo(qv.y), q3 = bfhi(qv.y);
        const float slope = exp2f(-0.5f * (float)(h + 1)), sink = sinks[h];
        const bf16_t* kb = ZA + (size_t)tok * ZAW + ZK + hk * 64 + i4 * 4;
        float sc[8];
#pragma unroll
        for (int jb = 0; jb < 8; ++jb) { sc[jb] = -1e30f;
#pragma unroll 2
            for (int kk = 0; kk < 16; ++kk) { const int dist = jb * 16 + kk; const bool valid = dist <= pos; const int dd = valid ? dist : 0;
                const uint2 kv = *(const uint2*)(kb - (size_t)dd * ZAW);
                float s = q0 * bflo(kv.x) + q1 * bfhi(kv.x) + q2 * bflo(kv.y) + q3 * bfhi(kv.y);
                s += __shfl_xor(s, 1); s += __shfl_xor(s, 2); s += __shfl_xor(s, 4); s += __shfl_xor(s, 8);
                s = valid ? (s * 0.125f - slope * (float)dist) : -1e30f; sc[jb] = (i4 == kk) ? s : sc[jb]; } }
        float mx = sc[0];
#pragma unroll
        for (int jb = 1; jb < 8; ++jb) mx = fmaxf(mx, sc[jb]);
        mx = fmaxf(mx, __shfl_xor(mx, 1)); mx = fmaxf(mx, __shfl_xor(mx, 2)); mx = fmaxf(mx, __shfl_xor(mx, 4)); mx = fmaxf(mx, __shfl_xor(mx, 8));
        mx = fmaxf(mx, sink);
        float ps = 0.f;
#pragma unroll
        for (int jb = 0; jb < 8; ++jb) { sc[jb] = __expf(sc[jb] - mx); ps += sc[jb]; }
        ps += __shfl_xor(ps, 1); ps += __shfl_xor(ps, 2); ps += __shfl_xor(ps, 4); ps += __shfl_xor(ps, 8);
        const float inv = 1.0f / (ps + __expf(sink - mx));
        float o0 = 0.f, o1 = 0.f, o2 = 0.f, o3 = 0.f;
#pragma unroll
        for (int jb = 0; jb < 8; ++jb) {
#pragma unroll 2
            for (int kk = 0; kk < 16; ++kk) { const int dist = jb * 16 + kk; const float pm = __shfl(sc[jb], (lane & 48) | kk); const int dd = dist <= pos ? dist : 0;
                const uint2 vv = *(const uint2*)(kb - (size_t)dd * ZAW + (ZVV - ZK));
                o0 += pm * bflo(vv.x); o1 += pm * bfhi(vv.x); o2 += pm * bflo(vv.y); o3 += pm * bfhi(vv.y); } }
        uint2 w; w.x = cvt_pk_bf16(o0 * inv, o1 * inv); w.y = cvt_pk_bf16(o2 * inv, o3 * inv);
        *(uint2*)(OBo + (size_t)tok * 1024 + h * 64 + i4 * 4) = w;
    }
}
__device__ __forceinline__ void mixA_naive(const bf16_t* __restrict__ ZA, const float* __restrict__ lng, const float* __restrict__ lnb, const float* __restrict__ ws_, const float* __restrict__ bs_, bf16_t* __restrict__ OA, unsigned char* shm) {
    float* st = (float*)shm;
    bf16_t* vn = (bf16_t*)(shm + 1024);
    const int tid = threadIdx.x, lane = tid & 63, wid = __builtin_amdgcn_readfirstlane(tid >> 6);
    for (int task = blockIdx.x; task < 512; task += gridDim.x) {
        const int c = task >> 2, g = task & 3, tok0 = c * 128;
#pragma unroll 1
        for (int jb = 0; jb < 4; ++jb) { u32x4 av[4], bv[4];
#pragma unroll
            for (int jj = 0; jj < 4; ++jj) { const bf16_t* vp = ZA + (size_t)(tok0 + 16 * wid + 4 * jb + jj) * ZAW + ZV + lane * 16; av[jj] = *(const u32x4*)vp; bv[jj] = *(const u32x4*)(vp + 8); }
#pragma unroll
            for (int jj = 0; jj < 4; ++jj) { const int s = 16 * wid + 4 * jb + jj; const u32x4 a = av[jj], b2 = bv[jj]; float x[16];
                x[0] = bflo(a.x); x[1] = bfhi(a.x); x[2] = bflo(a.y); x[3] = bfhi(a.y); x[4] = bflo(a.z); x[5] = bfhi(a.z); x[6] = bflo(a.w); x[7] = bfhi(a.w);
                x[8] = bflo(b2.x); x[9] = bfhi(b2.x); x[10] = bflo(b2.y); x[11] = bfhi(b2.y); x[12] = bflo(b2.z); x[13] = bfhi(b2.z); x[14] = bflo(b2.w); x[15] = bfhi(b2.w);
                float sm = 0.f;
#pragma unroll
                for (int e = 0; e < 16; ++e) sm += x[e];
                sm = wave_sum(sm); const float mu = sm * (1.0f / 1024.0f); float sq = 0.f;
#pragma unroll
                for (int e = 0; e < 16; ++e) { const float d = x[e] - mu; sq += d * d; }
                sq = wave_sum(sq); const float rstd = rsqrtf(sq * (1.0f / 1024.0f) + 1e-6f);
                if (lane == 0) { st[2 * s] = mu; st[2 * s + 1] = rstd; } } }
        __syncthreads();
        const int d = tid & 255, th = __builtin_amdgcn_readfirstlane(tid >> 8);
        { const float gg = lng[g * 256 + d], bb = lnb[g * 256 + d];
          for (int s = th * 64; s < th * 64 + 64; ++s) { const float v = bf2f(ZA[(size_t)(tok0 + s) * ZAW + ZV + g * 256 + d]);
              const float y = (v - st[2 * s]) * st[2 * s + 1] * gg + bb; vn[s * 256 + d] = (bf16_t)(cvt_pk_bf16(y, 0.f) & 0xffffu); } }
        __syncthreads();
        for (int t = th * 64; t < th * 64 + 64; ++t) { const float* wr_ = ws_ + (size_t)(g * 128 + t) * 128; float acc = 0.f;
#pragma unroll 4
            for (int s = 0; s <= t; ++s) acc += wr_[s] * bf2f(vn[s * 256 + d]);
            const float mixed = acc + bs_[g * 128 + t]; const float uu = bf2f(ZA[(size_t)(tok0 + t) * ZAW + ZU + g * 256 + d]);
            OA[(size_t)(tok0 + t) * 1024 + g * 256 + d] = (bf16_t)(cvt_pk_bf16(uu * mixed, 0.f) & 0xffffu); }
        __syncthreads();
    }
}


typedef short s16x4 __attribute__((ext_vector_type(4)));
using pg8::bf16x8;
__device__ __forceinline__ bf16x8 pack8(const f32x4& a, const f32x4& b) {
    u32x4 w; w.x = cvt_pk_bf16(a[0], a[1]); w.y = cvt_pk_bf16(a[2], a[3]); w.z = cvt_pk_bf16(b[0], b[1]); w.w = cvt_pk_bf16(b[2], b[3]); return __builtin_bit_cast(bf16x8, w);
}
__device__ __forceinline__ bf16x8 cat44(const s16x4& a, const s16x4& b) { return (bf16x8){a[0], a[1], a[2], a[3], b[0], b[1], b[2], b[3]}; }
__device__ __forceinline__ s16x4 tr_read(const unsigned char* p) { return __builtin_amdgcn_ds_read_tr16_b64_v4i16((PG8_LAS s16x4*)p); }
#define MFMA16(a, b, c) __builtin_amdgcn_mfma_f32_16x16x32_bf16((a), (b), (c), 0, 0, 0)

__device__ __forceinline__ void mixC_mfma(const bf16_t* __restrict__ ZA, const bf16_t* __restrict__ MK, const bf16_t* __restrict__ VT, bf16_t* __restrict__ OC) {
    int tix_ = threadIdx.x; asm volatile("" : "+v"(tix_));
    int bid_ = blockIdx.x, gdim_ = gridDim.x; asm volatile("" : "+s"(bid_), "+s"(gdim_));
    const int lane = tix_ & 63, i = lane & 15, g = lane >> 4;
    const int gw = __builtin_amdgcn_readfirstlane(bid_ * 8 + (tix_ >> 6)), GW = gdim_ * 8;
    for (int task_ = gw; task_ < (T_TOK / 16) * 4 * MIXC_REP; task_ += GW) { const int task = task_ % ((T_TOK / 16) * 4);
        const int h = task & 3, t0 = (task >> 2) * 16, b = t0 >> 12;
        f32x4 s[16];
#pragma unroll
        for (int mt = 0; mt < 16; ++mt) s[mt] = (f32x4){0.f, 0.f, 0.f, 0.f};
        const bf16_t* qp = ZA + (size_t)(t0 + i) * ZAW + ZMQ + h * 256 + 8 * g;
        const bf16_t* kp = MK + (size_t)(b * 256 + i) * DM + h * 256 + 8 * g;
#pragma unroll
        for (int ks = 0; ks < 8; ++ks) { const bf16x8 qf = *(const bf16x8*)(qp + 32 * ks);
#pragma unroll
            for (int mt = 0; mt < 16; ++mt) { const bf16x8 kf = *(const bf16x8*)(kp + (size_t)(16 * mt) * DM + 32 * ks); s[mt] = MFMA16(kf, qf, s[mt]); } }
        float mx = -3.0e38f;
#pragma unroll
        for (int mt = 0; mt < 16; ++mt) mx = fmaxf(fmaxf(fmaxf(s[mt][0], s[mt][1]), fmaxf(s[mt][2], s[mt][3])), mx);
        mx = fmaxf(mx, __shfl_xor(mx, 16)); mx = fmaxf(mx, __shfl_xor(mx, 32));
        float sum = 0.f;
#pragma unroll
        for (int mt = 0; mt < 16; ++mt)
#pragma unroll
            for (int r = 0; r < 4; ++r) { const float e = __expf((s[mt][r] - mx) * 0.0625f); s[mt][r] = e; sum += e; }
        sum += __shfl_xor(sum, 16); sum += __shfl_xor(sum, 32);
        const float inv = 1.0f / sum;
        bf16x8 pf[8];
#pragma unroll
        for (int ks = 0; ks < 8; ++ks) pf[ks] = pack8(s[2 * ks], s[2 * ks + 1]);
        const bf16_t* vp = VT + (size_t)((b * 4 + h) * 256 + i) * 256 + 4 * g;
        bf16_t* op = OC + (size_t)(t0 + i) * 1024 + h * 256 + 4 * g;
#pragma unroll 4
        for (int dt = 0; dt < 16; ++dt) { f32x4 o = (f32x4){0.f, 0.f, 0.f, 0.f};
#pragma unroll
            for (int ks = 0; ks < 8; ++ks) { const s16x4 lo = *(const s16x4*)(vp + (size_t)(16 * dt) * 256 + 32 * ks), hi = *(const s16x4*)(vp + (size_t)(16 * dt) * 256 + 32 * ks + 16);
                o = MFMA16(cat44(lo, hi), pf[ks], o); }
            uint2 w; w.x = cvt_pk_bf16(o[0] * inv, o[1] * inv); w.y = cvt_pk_bf16(o[2] * inv, o[3] * inv); *(uint2*)(op + 16 * dt) = w; }
    }
}


__device__ __forceinline__ void mixC_lds(const bf16_t* __restrict__ ZA, const bf16_t* __restrict__ MK, const bf16_t* __restrict__ VT, bf16_t* __restrict__ OC, unsigned char* shm) {
    int bid_ = blockIdx.x, gdim_ = gridDim.x; asm volatile("" : "+s"(bid_), "+s"(gdim_));
    int tix_ = threadIdx.x; asm volatile("" : "+v"(tix_));
    constexpr int RS = 528;
    const int tid = tix_, lane = tid & 63, w = __builtin_amdgcn_readfirstlane(tid >> 6), i = lane & 15, g = lane >> 4;
    for (int task = bid_; task < 256; task += gdim_) {
        const int chunk = task & 15, h = (task >> 4) & 3, b = task >> 6;
        const int tokbase = b * SEQ + chunk * 256 + 32 * w;
        f32x4 s[2][16];
#pragma unroll
        for (int mt = 0; mt < 16; ++mt) { s[0][mt] = (f32x4){0.f, 0.f, 0.f, 0.f}; s[1][mt] = (f32x4){0.f, 0.f, 0.f, 0.f}; }
        const bf16_t* qp = ZA + (size_t)(tokbase + i) * ZAW + ZMQ + h * 256 + 8 * g;
        bf16x8 qf[2][8];
#pragma unroll
        for (int ks = 0; ks < 8; ++ks) { qf[0][ks] = *(const bf16x8*)(qp + 32 * ks); qf[1][ks] = *(const bf16x8*)(qp + (size_t)16 * ZAW + 32 * ks); }
#pragma unroll
        for (int p = 0; p < 2; ++p) {
            __syncthreads();
#pragma unroll
            for (int it = 0; it < 8; ++it) { const int item = tid + 512 * it; const int ch = item & 31, r = item >> 5;
                const u32x4 v = *(const u32x4*)(MK + (size_t)(b * 256 + 128 * p + r) * DM + h * 256 + 8 * ch); *(u32x4*)(shm + r * RS + ch * 16) = v; }
            __syncthreads();
#pragma unroll
            for (int ks = 0; ks < 8; ++ks) { const bf16x8 q0 = qf[0][ks], q1 = qf[1][ks];
#pragma unroll
                for (int mt = 0; mt < 8; ++mt) { const bf16x8 kf = *(const bf16x8*)(shm + (16 * mt + i) * RS + (32 * ks + 8 * g) * 2);
                    s[0][8 * p + mt] = MFMA16(kf, q0, s[0][8 * p + mt]); s[1][8 * p + mt] = MFMA16(kf, q1, s[1][8 * p + mt]); } }
        }
        bf16x8 pf[2][8]; float inv[2];
#pragma unroll
        for (int qt = 0; qt < 2; ++qt) {
            float mx = -3.0e38f;
#pragma unroll
            for (int mt = 0; mt < 16; ++mt) mx = fmaxf(fmaxf(fmaxf(s[qt][mt][0], s[qt][mt][1]), fmaxf(s[qt][mt][2], s[qt][mt][3])), mx);
            mx = fmaxf(mx, __shfl_xor(mx, 16)); mx = fmaxf(mx, __shfl_xor(mx, 32));
            float sum = 0.f;
#pragma unroll
            for (int mt = 0; mt < 16; ++mt)
#pragma unroll
                for (int r = 0; r < 4; ++r) { const float e = __expf((s[qt][mt][r] - mx) * 0.0625f); s[qt][mt][r] = e; sum += e; }
            sum += __shfl_xor(sum, 16); sum += __shfl_xor(sum, 32);
            inv[qt] = 1.0f / sum;
#pragma unroll
            for (int ks = 0; ks < 8; ++ks) pf[qt][ks] = pack8(s[qt][2 * ks], s[qt][2 * ks + 1]);
        }
        bf16_t* op = OC + (size_t)(tokbase + i) * 1024 + h * 256 + 4 * g;
#pragma unroll
        for (int p = 0; p < 2; ++p) {
            __syncthreads();
#pragma unroll
            for (int it = 0; it < 8; ++it) { const int item = tid + 512 * it; const int ch = item & 31, r = item >> 5;
                const u32x4 v = *(const u32x4*)(VT + (size_t)((b * 4 + h) * 256 + 128 * p + r) * 256 + 8 * ch); *(u32x4*)(shm + r * RS + ch * 16) = v; }
            __syncthreads();
#pragma unroll 2
            for (int dt = 0; dt < 8; ++dt) { f32x4 o0 = (f32x4){0.f, 0.f, 0.f, 0.f}, o1 = (f32x4){0.f, 0.f, 0.f, 0.f};
#pragma unroll
                for (int ks = 0; ks < 8; ++ks) { const unsigned char* vp = shm + (16 * dt + i) * RS + (32 * ks + 4 * g) * 2;
                    const bf16x8 vf = cat44(*(const s16x4*)vp, *(const s16x4*)(vp + 32));
                    o0 = MFMA16(vf, pf[0][ks], o0); o1 = MFMA16(vf, pf[1][ks], o1); }
                uint2 w0; w0.x = cvt_pk_bf16(o0[0] * inv[0], o0[1] * inv[0]); w0.y = cvt_pk_bf16(o0[2] * inv[0], o0[3] * inv[0]); *(uint2*)(op + 128 * p + 16 * dt) = w0;
                uint2 w1; w1.x = cvt_pk_bf16(o1[0] * inv[1], o1[1] * inv[1]); w1.y = cvt_pk_bf16(o1[2] * inv[1], o1[3] * inv[1]); *(uint2*)(op + (size_t)16 * 1024 + 128 * p + 16 * dt) = w1; }
        }
    }
}

__device__ __forceinline__ void mixB_mfma(const bf16_t* __restrict__ ZA, const float* __restrict__ sinks, bf16_t* __restrict__ OBo, unsigned char* shm) {
    int tix_ = threadIdx.x; asm volatile("" : "+v"(tix_));
    int bid_ = blockIdx.x, gdim_ = gridDim.x; asm volatile("" : "+s"(bid_), "+s"(gdim_));
    constexpr int RS = 144;
    unsigned char* Kl = shm; unsigned char* Vl = shm + 256 * RS;
    const int tid = tix_, lane = tid & 63, w = __builtin_amdgcn_readfirstlane(tid >> 6), i = lane & 15, g = lane >> 4;
    for (int task_ = bid_; task_ < 512 * MIXB_REP; task_ += gdim_) { const int task = task_ & 511;
        const int hk = task & 3, cb = (task >> 2) & 31, b = task >> 7; const int tokblk = b * SEQ + cb * 128;
#pragma unroll
        for (int it = 0; it < 8; ++it) { const int item = tid + 512 * it; const int ch = item & 7, kl = (item >> 3) & 255, which = item >> 11;
            const bool ok = (cb > 0) || (kl >= 128); const int tok = ok ? (tokblk - 128 + kl) : tokblk;
            u32x4 v = *(const u32x4*)(ZA + (size_t)tok * ZAW + (which ? ZVV : ZK) + hk * 64 + 8 * ch);
            if (!ok) v = (u32x4){0u, 0u, 0u, 0u};
            *(u32x4*)((which ? Vl : Kl) + kl * RS + ch * 16) = v; }
        __syncthreads();
        const int t0 = tokblk + 16 * w;
        bf16x8 qall[4][2];
#pragma unroll
        for (int r = 0; r < 4; ++r) { const bf16_t* qp = ZA + (size_t)(t0 + i) * ZAW + ZQ + (hk * 4 + r) * 64 + 8 * g; qall[r][0] = *(const bf16x8*)qp; qall[r][1] = *(const bf16x8*)(qp + 32); }
#pragma unroll
        for (int r = 0; r < 4; ++r) { const int h = hk * 4 + r; int il = i; asm volatile("" : "+v"(il));
            const float slope = exp2f(-0.5f * (float)(h + 1)), sink = sinks[h];
            const int dmax = min(127, 16 * w + 128 + il - (cb > 0 ? 0 : 128));
            const bf16x8 qf0 = qall[r][0], qf1 = qall[r][1];
            f32x4 s[10];
            s[0] = (f32x4){0.f, 0.f, 0.f, 0.f};
#pragma unroll
            for (int kt = 1; kt < 10; ++kt) { const int ktl = w - 1 + kt; const unsigned char* kr = Kl + (16 * ktl + i) * RS + 16 * g;
                f32x4 a = (f32x4){0.f, 0.f, 0.f, 0.f};
                a = MFMA16(*(const bf16x8*)kr, qf0, a); a = MFMA16(*(const bf16x8*)(kr + 64), qf1, a);
#pragma unroll
                for (int rr = 0; rr < 4; ++rr) { const int dist = 144 + il - 16 * kt - 4 * g - rr;
                    const bool valid = (unsigned)dist <= (unsigned)dmax;
                    a[rr] = valid ? (a[rr] * 0.125f - slope * (float)dist) : -1e30f; }
                s[kt] = a; }
            float mx = sink;
#pragma unroll
            for (int kt = 1; kt < 10; ++kt) mx = fmaxf(fmaxf(fmaxf(s[kt][0], s[kt][1]), fmaxf(s[kt][2], s[kt][3])), mx);
            mx = fmaxf(mx, __shfl_xor(mx, 16)); mx = fmaxf(mx, __shfl_xor(mx, 32));
            float sum = 0.f;
#pragma unroll
            for (int kt = 1; kt < 10; ++kt)
#pragma unroll
                for (int rr = 0; rr < 4; ++rr) { const float e = __expf(s[kt][rr] - mx); s[kt][rr] = e; sum += e; }
            sum += __shfl_xor(sum, 16); sum += __shfl_xor(sum, 32);
            const float inv = 1.0f / (sum + __expf(sink - mx));
            bf16x8 pf[5];
#pragma unroll
            for (int k5 = 0; k5 < 5; ++k5) pf[k5] = pack8(s[2 * k5], s[2 * k5 + 1]);
            bf16_t* op = OBo + (size_t)(t0 + i) * 1024 + h * 64 + 4 * g;
#pragma unroll
            for (int dt = 0; dt < 4; ++dt) { f32x4 o = (f32x4){0.f, 0.f, 0.f, 0.f};
#pragma unroll
                for (int k5 = 0; k5 < 5; ++k5) { int kt0 = w - 1 + 2 * k5; const int kt1 = kt0 + 1; kt0 = kt0 < 0 ? 0 : kt0;
                    const s16x4 lo = tr_read(Vl + (16 * kt0 + 4 * g + (i >> 2)) * RS + (16 * dt + 4 * (i & 3)) * 2);
                    const s16x4 hi = tr_read(Vl + (16 * kt1 + 4 * g + (i >> 2)) * RS + (16 * dt + 4 * (i & 3)) * 2);
                    o = MFMA16(cat44(lo, hi), pf[k5], o); }
                uint2 wv; wv.x = cvt_pk_bf16(o[0] * inv, o[1] * inv); wv.y = cvt_pk_bf16(o[2] * inv, o[3] * inv); *(uint2*)(op + 16 * dt) = wv; }
        }
        __syncthreads();
    }
}

__device__ __forceinline__ void mixA_mfma(const bf16_t* __restrict__ ZA, const float* __restrict__ lng, const float* __restrict__ lnb, const bf16_t* __restrict__ WSB, const float* __restrict__ bs_, bf16_t* __restrict__ OA, unsigned char* shm) {
    int bid_ = blockIdx.x, gdim_ = gridDim.x; asm volatile("" : "+s"(bid_), "+s"(gdim_));
    int tix_ = threadIdx.x; asm volatile("" : "+v"(tix_));
    constexpr int RS = 528;
    float* st = (float*)shm; unsigned char* vn = shm + 1024; constexpr int WRS = 272; unsigned char* wl = shm + 1024 + 128 * RS;
    const int tid = tix_, lane = tid & 63, wid = __builtin_amdgcn_readfirstlane(tid >> 6), i = lane & 15, g4 = lane >> 4;
    for (int task_ = bid_; task_ < 256 * MIXA_REP; task_ += gdim_) { const int task = task_ & 255;
        const int c = task >> 1, gp = task & 1, tok0 = c * 128;
        __syncthreads();
#pragma unroll 1
        for (int jb = 0; jb < 4; ++jb) { u32x4 av[4], bv[4];
#pragma unroll
            for (int jj = 0; jj < 4; ++jj) { const bf16_t* vp = ZA + (size_t)(tok0 + 16 * wid + 4 * jb + jj) * ZAW + ZV + lane * 16; av[jj] = *(const u32x4*)vp; bv[jj] = *(const u32x4*)(vp + 8); }
#pragma unroll
            for (int jj = 0; jj < 4; ++jj) { const int s = 16 * wid + 4 * jb + jj; const u32x4 a = av[jj], b2 = bv[jj]; float x[16];
                x[0] = bflo(a.x); x[1] = bfhi(a.x); x[2] = bflo(a.y); x[3] = bfhi(a.y); x[4] = bflo(a.z); x[5] = bfhi(a.z); x[6] = bflo(a.w); x[7] = bfhi(a.w);
                x[8] = bflo(b2.x); x[9] = bfhi(b2.x); x[10] = bflo(b2.y); x[11] = bfhi(b2.y); x[12] = bflo(b2.z); x[13] = bfhi(b2.z); x[14] = bflo(b2.w); x[15] = bfhi(b2.w);
                float sm = 0.f;
#pragma unroll
                for (int e = 0; e < 16; ++e) sm += x[e];
                sm = wave_sum(sm); const float mu = sm * (1.0f / 1024.0f); float sq = 0.f;
#pragma unroll
                for (int e = 0; e < 16; ++e) { const float d = x[e] - mu; sq += d * d; }
                sq = wave_sum(sq); const float rstd = rsqrtf(sq * (1.0f / 1024.0f) + 1e-6f);
                if (lane == 0) { st[2 * s] = mu; st[2 * s + 1] = rstd; } } }
#pragma unroll 1
        for (int gi = 0; gi < 2; ++gi) { const int grp = 2 * gp + gi;
            __syncthreads();
#pragma unroll
            for (int it = 0; it < 4; ++it) { const int idx = tid + 512 * it; const int row = idx >> 4, ch = idx & 15;
                *(u32x4*)(wl + row * WRS + ch * 16) = *(const u32x4*)(WSB + (size_t)grp * 16384 + row * 128 + ch * 8); }
            { const int dg = tid & 31; const float4 ga = *(const float4*)(lng + grp * 256 + 8 * dg), gb = *(const float4*)(lng + grp * 256 + 8 * dg + 4), ba = *(const float4*)(lnb + grp * 256 + 8 * dg), bb = *(const float4*)(lnb + grp * 256 + 8 * dg + 4);
#pragma unroll
              for (int it = 0; it < 8; ++it) { const int s = (tid >> 5) + 16 * it; const float mu = st[2 * s], rs = st[2 * s + 1];
                  const u32x4 v = *(const u32x4*)(ZA + (size_t)(tok0 + s) * ZAW + ZV + grp * 256 + 8 * dg);
                  u32x4 wv;
                  wv.x = cvt_pk_bf16((bflo(v.x) - mu) * rs * ga.x + ba.x, (bfhi(v.x) - mu) * rs * ga.y + ba.y); wv.y = cvt_pk_bf16((bflo(v.y) - mu) * rs * ga.z + ba.z, (bfhi(v.y) - mu) * rs * ga.w + ba.w);
                  wv.z = cvt_pk_bf16((bflo(v.z) - mu) * rs * gb.x + bb.x, (bfhi(v.z) - mu) * rs * gb.y + bb.y); wv.w = cvt_pk_bf16((bflo(v.w) - mu) * rs * gb.z + bb.z, (bfhi(v.w) - mu) * rs * gb.w + bb.w);
                  *(u32x4*)(vn + s * RS + dg * 16) = wv; } }
            __syncthreads();
            f32x4 acc[8][2];
#pragma unroll
            for (int tt = 0; tt < 8; ++tt) { acc[tt][0] = (f32x4){0.f, 0.f, 0.f, 0.f}; acc[tt][1] = (f32x4){0.f, 0.f, 0.f, 0.f}; }
            uint2 uw[8][2]; float bias[8];
#pragma unroll
            for (int tt = 0; tt < 8; ++tt) { bias[tt] = bs_[grp * 128 + 16 * tt + i];
#pragma unroll
                for (int nt = 0; nt < 2; ++nt) uw[tt][nt] = *(const uint2*)(ZA + (size_t)(tok0 + 16 * tt + i) * ZAW + ZU + grp * 256 + 32 * wid + 16 * nt + 4 * g4); }
#pragma unroll
            for (int ks = 0; ks < 4; ++ks) { bf16x8 vfr[2];
#pragma unroll
                for (int nt = 0; nt < 2; ++nt) { const unsigned char* bp = vn + (32 * ks + 8 * g4 + (i >> 2)) * RS + (32 * wid + 16 * nt + 4 * (i & 3)) * 2;
                    vfr[nt] = cat44(tr_read(bp), tr_read(bp + 4 * RS)); }
#pragma unroll
                for (int tt = 0; tt < 8; ++tt) if (ks <= tt / 2) { const bf16x8 wf = *(const bf16x8*)(wl + (16 * tt + i) * WRS + (32 * ks + 8 * g4) * 2);
                    acc[tt][0] = MFMA16(vfr[0], wf, acc[tt][0]); acc[tt][1] = MFMA16(vfr[1], wf, acc[tt][1]); } }
#pragma unroll
            for (int tt = 0; tt < 8; ++tt) { const int t = 16 * tt + i;
#pragma unroll
                for (int nt = 0; nt < 2; ++nt) { const int dcol = grp * 256 + 32 * wid + 16 * nt + 4 * g4; const uint2 u2 = uw[tt][nt];
                    uint2 ow; ow.x = cvt_pk_bf16(bflo(u2.x) * (acc[tt][nt][0] + bias[tt]), bfhi(u2.x) * (acc[tt][nt][1] + bias[tt])); ow.y = cvt_pk_bf16(bflo(u2.y) * (acc[tt][nt][2] + bias[tt]), bfhi(u2.y) * (acc[tt][nt][3] + bias[tt]));
                    *(uint2*)(OA + (size_t)(tok0 + t) * 1024 + dcol) = ow; } }
        }
    }
    __syncthreads();
}
__device__ __forceinline__ void build_wsb(const float* __restrict__ ws_, bf16_t* __restrict__ WSB) {
    int tix_ = threadIdx.x; asm volatile("" : "+v"(tix_));
    int bid_ = blockIdx.x, gdim_ = gridDim.x; asm volatile("" : "+s"(bid_), "+s"(gdim_));
    for (int e = bid_ * 512 + tix_; e < 4 * 128 * 128; e += gdim_ * 512) { const int s = e & 127, t = (e >> 7) & 127;
        WSB[e] = (s <= t) ? (bf16_t)(cvt_pk_bf16(ws_[e], 0.f) & 0xffffu) : (bf16_t)0; }
}

#define XB_TMO      128
#define XB_XCNT(j)  (256  + 64 * (j))
#define XB_XSUB(j)  (1280 + 64 * (j))
#define XB_XGEN(j)  (2304 + 64 * (j))
#define XB_TOP      3328
#define XB_TOPGEN   3392
#define XCD_BAR_WORDS 3456
#define XB_SPIN_CAP (1u << 18)
#define LAS __attribute__((address_space(3)))

__device__ __forceinline__ unsigned xb_ld(unsigned* p)              { return __hip_atomic_load(p, __ATOMIC_RELAXED, __HIP_MEMORY_SCOPE_AGENT); }
__device__ __forceinline__ unsigned xb_add(unsigned* p, unsigned v) { return __hip_atomic_fetch_add(p, v, __ATOMIC_RELAXED, __HIP_MEMORY_SCOPE_AGENT); }
__device__ __forceinline__ unsigned xb_xcc_id() { return (unsigned)__builtin_amdgcn_s_getreg((3 << 11) | 20) & 0xFu; }
#define XB_SPIN(cond, bar) do { unsigned _sp = 0; while (cond) { __builtin_amdgcn_s_sleep(1); \
    if ((++_sp & 255u) == 0u) { if (xb_ld(&(bar)[XB_TMO])) break; if (_sp > XB_SPIN_CAP) { atomicAdd(&(bar)[XB_TMO], 1u); break; } } } } while (0)

struct XcdBarrier {
    unsigned* bar; unsigned x;
    volatile LAS unsigned* st;
};

__device__ __forceinline__ XcdBarrier xcd_barrier_post(unsigned* bar, volatile LAS unsigned* st) {
    XcdBarrier b; b.bar = bar; b.x = xb_xcc_id(); b.st = st;
    if (threadIdx.x == 0) (void)xb_add(&bar[XB_XCNT(b.x)], 1u);
    return b;
}
__device__ __forceinline__ void xcd_barrier_complete(unsigned* bar, unsigned x, unsigned& nloc, unsigned& nx) {
    const unsigned G = gridDim.x * gridDim.y * gridDim.z;
    unsigned sum, cnt, mine, sp = 0u;
    for (;;) {
        sum = 0u; cnt = 0u; mine = 0u;
#pragma unroll
        for (unsigned j = 0; j < 16; ++j) { const unsigned c = xb_ld(&bar[XB_XCNT(j)]); sum += c; cnt += (c > 0u) ? 1u : 0u; mine = (j == x) ? c : mine; }
        if (sum == G) break;
        __builtin_amdgcn_s_sleep(1);
        if ((++sp & 255u) == 0u) { if (xb_ld(&bar[XB_TMO])) break; if (sp > XB_SPIN_CAP) { atomicAdd(&bar[XB_TMO], 1u); break; } }
    }
    nloc = mine > 0u ? mine : 1u; nx = cnt > 0u ? cnt : 1u;
}

__device__ __forceinline__ void xcd_barrier(const XcdBarrier& b) {
    asm volatile("s_waitcnt vmcnt(0)" ::: "memory");
    __syncthreads();
    if (threadIdx.x == 0) {
        unsigned* bar = b.bar;
        __builtin_amdgcn_s_waitcnt(0);
        unsigned nloc = b.st[0], nx = b.st[1];
        if (nloc == 0u) { xcd_barrier_complete(bar, b.x, nloc, nx); b.st[0] = nloc; b.st[1] = nx; }
        const unsigned old = xb_add(&bar[XB_XSUB(b.x)], 1u);
        const unsigned gen = old / nloc;
        if (old + 1u == (gen + 1u) * nloc) {
            __builtin_amdgcn_fence(__ATOMIC_RELEASE, "agent");
            asm volatile("s_waitcnt vmcnt(0)" ::: "memory");
            const unsigned og = xb_add(&bar[XB_TOP], 1u);
            const unsigned tg = og / nx;
            if (og + 1u == (tg + 1u) * nx) xb_add(&bar[XB_TOPGEN], 1u);
            else XB_SPIN(xb_ld(&bar[XB_TOPGEN]) == tg, bar);
            __builtin_amdgcn_fence(__ATOMIC_ACQUIRE, "agent");
            xb_add(&bar[XB_XGEN(b.x)], 1u);
            asm volatile("s_waitcnt vmcnt(0)" ::: "memory");
        } else {
            XB_SPIN(xb_ld(&bar[XB_XGEN(b.x)]) == gen, bar);
            __builtin_amdgcn_fence(__ATOMIC_ACQUIRE, "agent");
            asm volatile("s_waitcnt vmcnt(0)" ::: "memory");
        }
    }
    __syncthreads();
}


__device__ __forceinline__ void run_phase(const Params& p, const int ph, unsigned char* shm) {
    using namespace pg8;
    PG8_LAS unsigned char* lds = (PG8_LAS unsigned char*)shm;
    unsigned char* ws = p.ws; bf16_t* H16 = (bf16_t*)(ws + WS_H16);
    bf16_t* XN = (bf16_t*)(ws + WS_XN); bf16_t* ACT = (bf16_t*)(ws + WS_ACT); bf16_t* ZA = ACT; float* Y32 = (float*)(ws + WS_ACT); bf16_t* ZG = (bf16_t*)(ws + WS_ZG);
    bf16_t* OBb = (bf16_t*)(ws + WS_OB); bf16_t* MEMN = (bf16_t*)(ws + WS_MEMN); bf16_t* MKV = (bf16_t*)(ws + WS_MKV); bf16_t* VT = (bf16_t*)(ws + WS_VT); bf16_t* WSB = (bf16_t*)(ws + WS_WSB);
    int G = gridDim.x, c = blockIdx.x; asm volatile("" : "+s"(G), "+s"(c));
    if (ph == N_PHASES - 1) { norm_rows16<true>(H16, p.in[19], p.out, T_TOK); return; }
    const int l = ph / PH_PER_LAYER, q = ph % PH_PER_LAYER;
    switch (q) {
    case 0: {
        int cursor = 0; float* tile = (float*)shm;
        convert_t(p.in[3] + (size_t)l * DM * 2 * DFF, DM, 2 * DFF, (bf16_t*)(ws + WS_W_FFN1_IN), 1, cursor, tile, 1);
        convert_t(p.in[4] + (size_t)l * DFF * DM, DFF, DM, (bf16_t*)(ws + WS_W_FFN1_OUT), 0, cursor, tile, 1);
        convert_t(p.in[6] + (size_t)l * DM * INW, DM, INW, (bf16_t*)(ws + WS_W_WIN), 0, cursor, tile, 1);
        convert_t(p.in[13] + (size_t)l * DM * DM, DM, DM, (bf16_t*)(ws + WS_W_MEMKV), 0, cursor, tile, 1);
        for (int b = 0; b < 3; ++b) convert_t(p.in[14] + ((size_t)l * 3 + b) * 1024 * DM, 1024, DM, (bf16_t*)(ws + WS_W_BR) + (size_t)b * DM * 1024, 0, cursor, tile, 1);
        convert_t(p.in[15] + (size_t)l * DM * DM, DM, DM, (bf16_t*)(ws + WS_W_WOUT), 0, cursor, tile, 1);
        convert_t(p.in[17] + (size_t)l * DM * 2 * DFF, DM, 2 * DFF, (bf16_t*)(ws + WS_W_FFN2_IN), 1, cursor, tile, 1);
        convert_t(p.in[18] + (size_t)l * DFF * DM, DFF, DM, (bf16_t*)(ws + WS_W_FFN2_OUT), 0, cursor, tile, 1);
        if (l == 0) norm_rows<false>(p.in[0], p.in[2] + l * DM, XN, T_TOK); else norm_rows16<false>(H16, p.in[2] + l * DM, XN, T_TOK);
        norm_rows<false>(p.in[1], p.in[12] + l * DM, MEMN, NB * MEML);
        build_wsb(p.in[9] + (size_t)l * 4 * 128 * 128, WSB);
    } break;
    case 1: {
        { Gemm g{XN, (const bf16_t*)(ws + WS_W_FFN1_IN), T_TOK, 2 * DFF, DM}; StaticOrder S; S.init(g.M, g.N, G, c); S.rep = GEMM_REP; EpiSwiGLU E{ACT, DFF}; gemm_phase(lds, g, S, E); }
    } break;
    case 2: { Gemm g{ACT, (const bf16_t*)(ws + WS_W_FFN1_OUT), T_TOK, DM, DFF}; StaticOrder S; S.init(g.M, g.N, G, c); S.wgm = 4;
        if (l == 0) { EpiResid16<true> E{p.in[0], H16, 0.5f}; gemm_phase(lds, g, S, E); } else { EpiResid16<false> E{nullptr, H16, 0.5f}; gemm_phase(lds, g, S, E); } } break;
    case 3: norm_rows16<false>(H16, p.in[5] + l * DM, XN, T_TOK); break;
    case 4: {
        { Gemm g{XN, (const bf16_t*)(ws + WS_W_WIN), T_TOK, INW, DM}; StaticOrder S; S.init(g.M, g.N, G, c); S.rep = WIN_REP; EpiWin E{ZA, ZG}; gemm_phase(lds, g, S, E); }
        { Gemm g{MEMN, (const bf16_t*)(ws + WS_W_MEMKV), NB * MEML, DM, DM}; StaticOrder S; S.init(g.M, g.N, G, (c + 128) % G); EpiMemKV E{MKV, VT}; gemm_phase(lds, g, S, E); }
    } break;
    case 5: {
#if NAIVE_A
        mixA_naive(ZA, p.in[7] + l * 1024, p.in[8] + l * 1024, p.in[9] + (size_t)l * 4 * 128 * 128, p.in[10] + l * 4 * 128, OBb, shm);
#else
        mixA_mfma(ZA, p.in[7] + l * 1024, p.in[8] + l * 1024, WSB, p.in[10] + l * 4 * 128, OBb, shm);
#endif
#if NAIVE_B
        mixB_naive(ZA, p.in[11] + l * 16, OBb + (size_t)T_TOK * 1024);
#else
        mixB_mfma(ZA, p.in[11] + l * 16, OBb + (size_t)T_TOK * 1024, shm);
#endif
#if NAIVE_C
        mixC_naive(ZA, MKV, OBb + (size_t)2 * T_TOK * 1024);
#else
        mixC_lds(ZA, MKV, VT, OBb + (size_t)2 * T_TOK * 1024, shm);
#endif
    } break;
    case 6: { Gemm g{OBb, (const bf16_t*)(ws + WS_W_BR), T_TOK, DM, 1024, (size_t)T_TOK * 1024 * 2, (size_t)DM * 1024 * 2}; ChainOrder S; S.init(g.M, g.N, G, c); S.wgm = 4; EpiBranchChain E{ZG, XN}; gemm_phase(lds, g, S, E); } break;
    case 7: { Gemm g{XN, (const bf16_t*)(ws + WS_W_WOUT), T_TOK, DM, DM}; StaticOrder S; S.init(g.M, g.N, G, c); S.wgm = 4; EpiResid16<false> E{nullptr, H16, 1.0f}; gemm_phase(lds, g, S, E); } break;
    case 8: norm_rows16<false>(H16, p.in[16] + l * DM, XN, T_TOK); break;
    case 9: { Gemm g{XN, (const bf16_t*)(ws + WS_W_FFN2_IN), T_TOK, 2 * DFF, DM}; StaticOrder S; S.init(g.M, g.N, G, c); S.rep = GEMM_REP; EpiSwiGLU E{ACT, DFF}; gemm_phase(lds, g, S, E); } break;
    case 10: { Gemm g{ACT, (const bf16_t*)(ws + WS_W_FFN2_OUT), T_TOK, DM, DFF}; StaticOrder S; S.init(g.M, g.N, G, c); S.wgm = 4; EpiResid16<false> E{nullptr, H16, 0.5f}; gemm_phase(lds, g, S, E); } break;
    }
}

__global__ void __launch_bounds__(512, 2) mega_fwd(Params p, int ph_lo, int ph_hi) {
    extern __shared__ __attribute__((aligned(16))) unsigned char shm[];
    cg::grid_group grid = cg::this_grid();
#if MK_COOP
    const int lo = 0, hi = N_PHASES;
#else
    const int lo = ph_lo, hi = ph_hi;
#endif
#ifdef ONLY_PHASE
#define IN(k) ((k) == ONLY_PHASE)
#else
#define IN(k) (lo <= (k) && (k) < hi)
#endif
    if (threadIdx.x == 0) { ((unsigned*)(shm + 131072))[0] = 0u; ((unsigned*)(shm + 131072))[1] = 0u; ((unsigned*)(shm + 131072))[2] = 0u; ((unsigned*)(shm + 131072))[3] = 0u; }
    __syncthreads();
    XcdBarrier xbar = xcd_barrier_post((unsigned*)(p.ws + WS_BAR), (volatile LAS unsigned*)(shm + 131072));
#define SEAM(k) do { if ((k) == 0) grid.sync(); else xcd_barrier(xbar); } while (0)
#define PHASE(k) if (IN(k)) { auto ka = __builtin_amdgcn_kernarg_segment_ptr(); asm volatile("" : "+s"(ka)); Params pl; __builtin_memcpy(&pl, (const __attribute__((address_space(4))) Params*)ka, sizeof(Params)); run_phase(pl, (k), shm); if (IN((k) + 1)) { SEAM(k); if (SYNC_REP > 1) SEAM(k); } }
    PHASE(0) PHASE(1) PHASE(2) PHASE(3) PHASE(4) PHASE(5) PHASE(6) PHASE(7) PHASE(8) PHASE(9) PHASE(10)
    PHASE(11) PHASE(12) PHASE(13) PHASE(14) PHASE(15) PHASE(16) PHASE(17) PHASE(18) PHASE(19) PHASE(20) PHASE(21)
    PHASE(22)
#undef PHASE
#undef IN
}

constexpr int LDS_BYTES = 128 * 1024 + 16;
extern "C" void kernel_launch(void* const* d_in, const int* in_sizes, int n_in, void* d_out, int out_size, void* d_ws, size_t ws_size, hipStream_t stream) {
    static int grid = 0;
    if (grid == 0) {
        int dev = 0, cus = 0, per_cu = 0;
        (void)hipGetDevice(&dev); (void)hipDeviceGetAttribute(&cus, hipDeviceAttributeMultiprocessorCount, dev);
        (void)hipFuncSetAttribute((const void*)mega_fwd, hipFuncAttributeMaxDynamicSharedMemorySize, LDS_BYTES);
        (void)hipOccupancyMaxActiveBlocksPerMultiprocessor(&per_cu, (const void*)mega_fwd, 512, LDS_BYTES);
        if (per_cu < 1) { fprintf(stderr, "kernel_launch: occupancy query says %d blocks/CU\n", per_cu); per_cu = 1; }
        (void)hipGetLastError();
        grid = cus;
        if (ws_size < WS_END) fprintf(stderr, "kernel_launch: workspace too small: %zu < %zu\n", ws_size, (size_t)WS_END);
    }
    (void)hipMemsetAsync((unsigned char*)d_ws + WS_BAR, 0, 16384, stream);
    Params p{};
    for (int i = 0; i < 20; ++i) p.in[i] = (const float*)d_in[i];
    p.out = (float*)d_out; p.ws = (unsigned char*)d_ws;
#if MK_COOP
    int lo = 0, hi = N_PHASES; void* args[] = {&p, &lo, &hi};
    hipError_t e = hipLaunchCooperativeKernel((const void*)mega_fwd, dim3(grid), dim3(512), args, LDS_BYTES, stream);
    if (e != hipSuccess) fprintf(stderr, "cooperative launch failed: %s (grid %d)\n", hipGetErrorString(e), grid);
#else
    for (int ph = 0; ph < N_PHASES; ++ph) hipLaunchKernelGGL(mega_fwd, dim3(grid), dim3(512), LDS_BYTES, stream, p, ph, ph + 1);
#endif
}
```
